# Optimizing an MI355X kernel written in HIP

```python
import jax, jax.numpy as jnp
from jax import lax
import numpy as np

D_MODEL = 1024
BATCH = 8
SEQ = 2048
DEPTH = 1
DEC_BATCH = 32
DEC_SEQ = 16
PAST_LEN = 1024

CHUNK = 64
D_CONV = D_MODEL // 2
D_ATTN = D_MODEL - D_CONV
N_HEADS = 8
HEAD_DIM = D_ATTN // N_HEADS
CONV_WIDTH = 31
D_FF = -(-8 * D_MODEL // (3 * 256)) * 256
IN_COLS = 2 * D_CONV + 3 * D_ATTN + N_HEADS
Q_BLOCK = 128
EPS = 1e-6
NEG_INF = -1e30

kernel_name = 'hybrid_conformer_conv_fox_adaln_step'


def _rmsnorm(x, g):
    x32 = x.astype(jnp.float32)
    y = x32 * lax.rsqrt(jnp.mean(x32 * x32, axis=-1, keepdims=True) + EPS)
    return (y * g.astype(jnp.float32)).astype(x.dtype)


def _modulation(c, w_ada, b_ada):
    mod = jax.nn.silu(c) @ w_ada + b_ada
    return jnp.split(mod[:, None, :], 6, axis=-1)


def _mixer_inputs(x, shift, scale, norm1_g, w_in, b_f, q_norm_g, k_norm_g):
    b, t = x.shape[0], x.shape[1]
    h = _rmsnorm(x, norm1_g) * (1 + scale) + shift
    z = h @ w_in
    u_a, u_g, q, k, v, f = jnp.split(
        z, [D_CONV, 2 * D_CONV, 2 * D_CONV + D_ATTN, 2 * D_CONV + 2 * D_ATTN,
            2 * D_CONV + 3 * D_ATTN], axis=-1)
    u = u_a * jax.nn.sigmoid(u_g)
    q = _rmsnorm(q.reshape(b, t, N_HEADS, HEAD_DIM), q_norm_g)
    k = _rmsnorm(k.reshape(b, t, N_HEADS, HEAD_DIM), k_norm_g)
    v = v.reshape(b, t, N_HEADS, HEAD_DIM)
    logf = jax.nn.log_sigmoid((f + b_f).astype(jnp.float32))
    return u, q, k, v, logf


def _conv_module(u_hist, conv_w, conv_b, ln_g, ln_b):
    y = lax.conv_general_dilated(
        u_hist, conv_w[:, None, :], window_strides=(1,), padding='VALID',
        dimension_numbers=('NWC', 'WIO', 'NWC'), feature_group_count=D_CONV) + conv_b
    y32 = y.astype(jnp.float32)
    mu = jnp.mean(y32, axis=-1, keepdims=True)
    var = jnp.mean(jnp.square(y32 - mu), axis=-1, keepdims=True)
    y32 = (y32 - mu) * lax.rsqrt(var + EPS) * ln_g.astype(jnp.float32) + ln_b.astype(jnp.float32)
    return jax.nn.silu(y32).astype(u_hist.dtype)


def _attend(q, k, v, cum_q, cum_k, q_pos, k_pos):
    s = jnp.einsum('bqhd,bkhd->bhqk', q, k, preferred_element_type=jnp.float32) * (HEAD_DIM ** -0.5)
    s = s + (cum_q[..., :, None] - cum_k[..., None, :])
    mask = k_pos[None, :] <= q_pos[:, None]
    s = jnp.where(mask, s, NEG_INF)
    p = jax.nn.softmax(s, axis=-1)
    return jnp.einsum('bhqk,bkhd->bqhd', p.astype(v.dtype), v)


def _prompt_attention(q, k, v, logf):
    b, s = q.shape[0], q.shape[1]
    nb = s // Q_BLOCK
    cum = jnp.cumsum(logf, axis=1).transpose(0, 2, 1)
    qb = q.reshape(b, nb, Q_BLOCK, N_HEADS, HEAD_DIM).transpose(1, 0, 2, 3, 4)
    cb = cum.reshape(b, N_HEADS, nb, Q_BLOCK).transpose(2, 0, 1, 3)
    pb = jnp.arange(s).reshape(nb, Q_BLOCK)
    k_pos = jnp.arange(s)
    out = lax.map(lambda a: _attend(a[0], k, v, a[1], cum, a[2], k_pos), (qb, cb, pb))
    return out.transpose(1, 0, 2, 3, 4).reshape(b, s, D_ATTN)


def _sample_attention(q, k, v, logf, ck, cv, clf):
    b, t = q.shape[0], q.shape[1]
    p_len = ck.shape[1]
    k_all = jnp.concatenate([ck, k], axis=1)
    v_all = jnp.concatenate([cv, v], axis=1)
    lf_all = jnp.concatenate([clf.astype(jnp.float32), logf], axis=1)
    cum = jnp.cumsum(lf_all, axis=1).transpose(0, 2, 1)
    q_pos = p_len + jnp.arange(t)
    k_pos = jnp.arange(p_len + t)
    out = _attend(q, k_all, v_all, cum[:, :, p_len:], cum, q_pos, k_pos)
    return out.reshape(b, t, D_ATTN)


def _layer(x, c, past, w_ada, b_ada, norm1_g, w_in, b_f, q_norm_g, k_norm_g, conv_w, conv_b,
           conv_ln_g, conv_ln_b, w_out, norm2_g, w_gate, w_up, w_down):
    sh1, sc1, g1, sh2, sc2, g2 = _modulation(c, w_ada, b_ada)
    u, q, k, v, logf = _mixer_inputs(x, sh1, sc1, norm1_g, w_in, b_f, q_norm_g, k_norm_g)
    if past is None:
        u_hist = jnp.pad(u, ((0, 0), (CONV_WIDTH - 1, 0), (0, 0)))
        attn = _prompt_attention(q, k, v, logf)
    else:
        conv_state, ck, cv, clf = past
        u_hist = jnp.concatenate([conv_state.astype(u.dtype), u], axis=1)
        attn = _sample_attention(q, k, v, logf, ck, cv, clf)
    conv_out = _conv_module(u_hist, conv_w, conv_b, conv_ln_g, conv_ln_b)
    new_conv = u_hist[:, u_hist.shape[1] - (CONV_WIDTH - 1):]
    mix = jnp.concatenate([conv_out, attn.astype(conv_out.dtype)], axis=-1) @ w_out
    x = x + g1 * mix
    h = _rmsnorm(x, norm2_g) * (1 + sc2) + sh2
    x = x + g2 * ((jax.nn.silu(h @ w_gate) * (h @ w_up)) @ w_down)
    return x, (k, v, logf, new_conv)


def setup_inputs(seed: int = 0) -> dict:
    key = jax.random.key(seed)
    ks = jax.random.split(key, 24)

    def nrm(k, shape, scale):
        return jax.random.normal(k, shape, jnp.float32) * scale

    L = DEPTH
    return {
        'x_prompt': nrm(ks[0], (BATCH, SEQ, D_MODEL), 1.0),
        'x_sample': nrm(ks[1], (DEC_BATCH, DEC_SEQ, D_MODEL), 1.0),
        'cache_k': nrm(ks[2], (L, DEC_BATCH, PAST_LEN, N_HEADS, HEAD_DIM), 1.0),
        'cache_v': nrm(ks[3], (L, DEC_BATCH, PAST_LEN, N_HEADS, HEAD_DIM), 1.0),
        'cache_logf': jax.nn.log_sigmoid(2.0 + nrm(ks[4], (L, DEC_BATCH, PAST_LEN, N_HEADS), 1.0)),
        'state_conv': nrm(ks[5], (L, DEC_BATCH, CONV_WIDTH - 1, D_CONV), 0.5),
        'c_prompt': nrm(ks[6], (BATCH, D_MODEL), 1.0),
        'c_sample': nrm(ks[7], (DEC_BATCH, D_MODEL), 1.0),
        'w_ada': nrm(ks[8], (L, D_MODEL, 6 * D_MODEL), D_MODEL ** -0.5),
        'b_ada': nrm(ks[9], (L, 6 * D_MODEL), 0.02),
        'norm1_g': 1.0 + nrm(ks[10], (L, D_MODEL), 0.02),
        'w_in': nrm(ks[11], (L, D_MODEL, IN_COLS), D_MODEL ** -0.5),
        'b_f': 2.0 + nrm(ks[12], (L, N_HEADS), 0.5),
        'q_norm_g': 1.0 + nrm(ks[13], (L, N_HEADS, HEAD_DIM), 0.02),
        'k_norm_g': 1.0 + nrm(ks[14], (L, N_HEADS, HEAD_DIM), 0.02),
        'conv_w': nrm(ks[15], (L, CONV_WIDTH, D_CONV), CONV_WIDTH ** -0.5),
        'conv_b': nrm(ks[16], (L, D_CONV), 0.02),
        'conv_ln_g': 1.0 + nrm(ks[17], (L, D_CONV), 0.02),
        'conv_ln_b': nrm(ks[18], (L, D_CONV), 0.02),
        'w_out': nrm(ks[19], (L, D_MODEL, D_MODEL), D_MODEL ** -0.5),
        'norm2_g': 1.0 + nrm(ks[20], (L, D_MODEL), 0.02),
        'w_gate': nrm(ks[21], (L, D_MODEL, D_FF), D_MODEL ** -0.5),
        'w_up': nrm(ks[22], (L, D_MODEL, D_FF), D_MODEL ** -0.5),
        'w_down': nrm(ks[23], (L, D_FF, D_MODEL), D_FF ** -0.5),
    }


def reference(x_prompt, x_sample, cache_k, cache_v, cache_logf, state_conv, c_prompt, c_sample,
              w_ada, b_ada, norm1_g, w_in, b_f, q_norm_g, k_norm_g, conv_w, conv_b, conv_ln_g,
              conv_ln_b, w_out, norm2_g, w_gate, w_up, w_down):
    yp, ys = x_prompt, x_sample
    st_p, st_s = [], []
    for l in range(DEPTH):
        w = (w_ada[l], b_ada[l], norm1_g[l], w_in[l], b_f[l], q_norm_g[l], k_norm_g[l], conv_w[l],
             conv_b[l], conv_ln_g[l], conv_ln_b[l], w_out[l], norm2_g[l], w_gate[l], w_up[l], w_down[l])
        yp, sp = _layer(yp, c_prompt, None, *w)
        ys, ss = _layer(ys, c_sample, (state_conv[l], cache_k[l], cache_v[l], cache_logf[l]), *w)
        st_p.append(sp)
        st_s.append(ss)
    k_prompt = jnp.stack([s[0] for s in st_p])
    v_prompt = jnp.stack([s[1] for s in st_p])
    logf_prompt = jnp.stack([s[2] for s in st_p])
    conv_prompt = jnp.stack([s[3] for s in st_p])
    k_sample = jnp.stack([s[0] for s in st_s])
    v_sample = jnp.stack([s[1] for s in st_s])
    logf_sample = jnp.stack([s[2] for s in st_s])
    conv_sample = jnp.stack([s[3] for s in st_s])
    return (yp, ys, k_prompt, v_prompt, logf_prompt, conv_prompt, k_sample, v_sample, logf_sample, conv_sample)
```

```cpp
#include <hip/hip_runtime.h>
#include <hip/hip_cooperative_groups.h>
#include <cstdio>
#include <cstdint>
namespace cg = cooperative_groups;
namespace pg8 {
#define PG8_LAS __attribute__((address_space(3)))
typedef unsigned short bf16_t;
typedef short bf16x8 __attribute__((ext_vector_type(8)));
typedef float f32x4 __attribute__((ext_vector_type(4)));
typedef unsigned u32x4 __attribute__((ext_vector_type(4)));
constexpr int BM = 256, BK = 64, HALF = 128, HTB = HALF * BK * 2  , STAGE_BYTES = 8 * HTB, NXCD = 8, WGM = 8;

__host__ __device__ __forceinline__ int lds_byte(int r, int c) { const int st = (r >> 4) * 2 + (c >> 5), rr = r & 15, cc = c & 31, ob = rr * 64 + cc * 2; return st * 1024 + (ob ^ (((ob >> 9) & 1) << 5)); }
__host__ __device__ __forceinline__ void stage_rc(int b, int& R, int& C) { const int st = b / 1024, sb = b % 1024, swz = sb ^ (((sb >> 9) & 1) << 5); R = (st >> 1) * 16 + swz / 64; C = (st & 1) * 32 + (swz % 64) / 2; }
__host__ __device__ __forceinline__ int perm32(int rho) { const int n = rho >> 4, i = rho & 15; return 8 * (i >> 2) + 4 * n + (i & 3); }

struct Unit { int pm, pn, koff, nt; };
struct Gemm { const bf16_t* A; const bf16_t* Bt; int M, N, K, ld; };

struct StaticOrder {
    int nM, nN, nwg, G, c;
    __host__ __device__ void init(int M, int N, int G_, int c_) { nM = M / BM; nN = N / BM; nwg = nM * nN; G = G_; c = c_; }
    __host__ __device__ bool next(int i, Unit& u) const {
        const long L = (long)i * G + c; if (L >= nwg) return false;
        int wgid = (int)L; { const int q = nwg / NXCD, r = nwg % NXCD, xcd = wgid % NXCD, off = wgid / NXCD; wgid = (xcd < r ? xcd * (q + 1) : r * (q + 1) + (xcd - r) * q) + off; }
        const int nig = WGM * nN, gid = wgid / nig, fm = gid * WGM, gsz = (nM - fm) < WGM ? (nM - fm) : WGM;
        u.pm = fm + ((wgid % nig) % gsz); u.pn = (wgid % nig) / gsz; u.koff = 0; u.nt = 0; return true;
    }
    __device__ __forceinline__ void a_ready(const Unit&) const {}
    __device__ __forceinline__ void done(const Unit&) const {}
};

__device__ __forceinline__ unsigned cvt_pk_bf16(float lo, float hi) { unsigned r; asm volatile("v_cvt_pk_bf16_f32 %0, %1, %2" : "=v"(r) : "v"(lo), "v"(hi)); return r; }
template <class Epi, class Sched, bool ALIGN_EPI = false, bool SP2 = false>
__device__ __forceinline__ void gemm_phase(PG8_LAS unsigned char* lds, const Gemm g, const Sched& S, const Epi& E) {
    const int tid = threadIdx.x, wid = __builtin_amdgcn_readfirstlane(tid >> 6), lane = tid & 63, wr = wid >> 2, wc = wid & 3, fr = lane & 15, fq = lane >> 4;
    const int K = g.K;
    unsigned voffA[2], voffB[2];
#pragma unroll
    for (int i = 0; i < 2; ++i) { int R, C; stage_rc(tid * 16 + i * 8192, R, C); const int Rb = Epi::PERM ? ((R & ~31) + perm32(R & 31)) : R;
        voffA[i] = (unsigned)(R * g.ld + C) * 2u; voffB[i] = (unsigned)(Rb * g.ld + C) * 2u; }
    const size_t kstep = (size_t)(BK * 2);
    const size_t hstep = (size_t)HALF * g.ld * 2;
    const size_t tstep = 2 * hstep;
    const unsigned ldsw = (unsigned)wid * 1024u;
    const int aoff = lds_byte(wr * 64 + fr, fq * 8), boff = lds_byte(wc * 32 + fr, fq * 8);
#define PG8_SA(b, h) (((b) * 2 + (h)) * HTB)
#define PG8_SB(b, h) ((4 + (b) * 2 + (h)) * HTB)
#define PG8_STAGE(bufoff, gbase, voff) do { _Pragma("unroll") for (int _i = 0; _i < 2; ++_i) \
        __builtin_amdgcn_global_load_lds((const unsigned*)((const char*)(gbase) + (voff)[_i]), (PG8_LAS unsigned*)(lds + (bufoff) + ldsw + _i * 8192), 16, 0, 0); } while (0)
#define PG8_LDA(dst, b, h) do { _Pragma("unroll") for (int m = 0; m < 4; ++m) _Pragma("unroll") for (int k = 0; k < 2; ++k) dst[m][k] = *(const PG8_LAS bf16x8*)(lds + PG8_SA(b, h) + aoff + m * 2048 + k * 1024); } while (0)
#define PG8_LDB(dst, b, h) do { _Pragma("unroll") for (int n = 0; n < 2; ++n) _Pragma("unroll") for (int k = 0; k < 2; ++k) dst[n][k] = *(const PG8_LAS bf16x8*)(lds + PG8_SB(b, h) + boff + n * 2048 + k * 1024); } while (0)
#define PG8_MMA(ai, bj, At, Bt) do { __builtin_amdgcn_s_setprio(1); _Pragma("unroll") for (int m = 0; m < 4; ++m) _Pragma("unroll") for (int n = 0; n < 2; ++n) _Pragma("unroll") for (int k = 0; k < 2; ++k) \
        acc[ai][bj][m][n] = __builtin_amdgcn_mfma_f32_16x16x32_bf16(Bt[n][k], At[m][k], acc[ai][bj][m][n], 0, 0, 0); __builtin_amdgcn_s_setprio(0); } while (0)
#define PG8_WAIT_V(n) asm volatile("s_waitcnt vmcnt(" #n ")" ::: "memory")
#define PG8_WAIT_L(n) asm volatile("s_waitcnt lgkmcnt(" #n ")" ::: "memory")
#define PG8_BAR __builtin_amdgcn_s_barrier()
#define PG8_SCHED __builtin_amdgcn_sched_barrier(0)
    Unit cur, nxt; int ui = 0;
    if (!S.next(0, cur)) return;
    f32x4 acc[2][2][4][2];
#pragma unroll
    for (int a = 0; a < 2; ++a)
#pragma unroll
        for (int b = 0; b < 2; ++b)
#pragma unroll
            for (int m = 0; m < 4; ++m)
#pragma unroll
                for (int n = 0; n < 2; ++n) acc[a][b][m][n] = (f32x4){0.f, 0.f, 0.f, 0.f};
    bf16x8 At[4][2], B0[2][2], B1[2][2];
    const char* cA = (const char*)g.A + (size_t)cur.pm * tstep + (size_t)cur.koff * 2; const char* cB = (const char*)g.Bt + (size_t)cur.pn * tstep + (size_t)cur.koff * 2;
    S.a_ready(cur);
    if constexpr (SP2) {
        PG8_STAGE(PG8_SB(0, 0), cB, voffB); PG8_STAGE(PG8_SB(0, 1), cB + hstep, voffB); PG8_STAGE(PG8_SA(0, 0), cA, voffA); PG8_STAGE(PG8_SA(0, 1), cA + hstep, voffA);
        if (wr == 1) PG8_BAR;
        PG8_WAIT_V(2); PG8_BAR;
        PG8_STAGE(PG8_SB(1, 0), cB + kstep, voffB); PG8_STAGE(PG8_SA(1, 0), cA + kstep, voffA); PG8_STAGE(PG8_SB(1, 1), cB + hstep + kstep, voffB);
        PG8_WAIT_V(6); PG8_BAR;
    } else {
        PG8_STAGE(PG8_SB(0, 0), cB, voffB); PG8_STAGE(PG8_SA(0, 0), cA, voffA); PG8_STAGE(PG8_SB(0, 1), cB + hstep, voffB); PG8_STAGE(PG8_SA(0, 1), cA + hstep, voffA);
        if (wr == 1) PG8_BAR;
        PG8_WAIT_V(4); PG8_BAR;
        PG8_STAGE(PG8_SB(1, 0), cB + kstep, voffB); PG8_STAGE(PG8_SA(1, 0), cA + kstep, voffA); PG8_STAGE(PG8_SB(1, 1), cB + hstep + kstep, voffB);
        PG8_WAIT_V(6); PG8_BAR;
    }
    for (;;) {
        const bool has_next = S.next(ui + 1, nxt);
        const int nt = cur.nt ? cur.nt : K / BK;
        const char* nA = has_next ? (const char*)g.A + (size_t)nxt.pm * tstep + (size_t)nxt.koff * 2 : cA; const char* nB = has_next ? (const char*)g.Bt + (size_t)nxt.pn * tstep + (size_t)nxt.koff * 2 : cB;
        for (int t = 0; t < nt; t += 2) {
            const bool last = (t == nt - 2);
            const char* a1 = cA + (size_t)(t + 1) * kstep;
            const char* a2 = last ? nA : cA + (size_t)(t + 2) * kstep; const char* b2 = last ? nB : cB + (size_t)(t + 2) * kstep;
            const char* a3 = a2 + kstep; const char* b3 = b2 + kstep;
            if (last && has_next) S.a_ready(nxt);
            if constexpr (SP2) {
            PG8_LDB(B0, 0, 0); PG8_LDB(B1, 0, 1); PG8_SCHED; PG8_LDA(At, 0, 0); PG8_STAGE(PG8_SA(1, 1), a1 + hstep, voffA);
            PG8_WAIT_V(8); PG8_WAIT_L(0); PG8_BAR; PG8_MMA(0, 0, At, B0); PG8_MMA(0, 1, At, B1); PG8_BAR; PG8_SCHED;
            PG8_LDA(At, 0, 1); PG8_STAGE(PG8_SB(0, 0), b2, voffB); PG8_STAGE(PG8_SB(0, 1), b2 + hstep, voffB); PG8_STAGE(PG8_SA(0, 0), a2, voffA);
            PG8_WAIT_V(8); PG8_WAIT_L(0); PG8_BAR; PG8_MMA(1, 0, At, B0); PG8_MMA(1, 1, At, B1); PG8_BAR; PG8_SCHED;
            PG8_LDB(B0, 1, 0); PG8_LDB(B1, 1, 1); PG8_SCHED; PG8_LDA(At, 1, 0); PG8_STAGE(PG8_SA(0, 1), a2 + hstep, voffA);
            PG8_WAIT_V(8); PG8_WAIT_L(0); PG8_BAR; PG8_MMA(0, 0, At, B0); PG8_MMA(0, 1, At, B1); PG8_BAR; PG8_SCHED;
            PG8_LDA(At, 1, 1); PG8_STAGE(PG8_SB(1, 0), b3, voffB); PG8_STAGE(PG8_SB(1, 1), b3 + hstep, voffB); PG8_STAGE(PG8_SA(1, 0), a3, voffA);
            PG8_WAIT_V(8); PG8_WAIT_L(0); PG8_BAR; PG8_MMA(1, 0, At, B0); PG8_MMA(1, 1, At, B1); PG8_BAR; PG8_SCHED;
            } else {
            PG8_LDB(B0, 0, 0); PG8_SCHED; PG8_LDA(At, 0, 0); PG8_STAGE(PG8_SA(1, 1), a1 + hstep, voffA);
            PG8_WAIT_L(8); PG8_BAR; PG8_WAIT_L(0); PG8_MMA(0, 0, At, B0); PG8_BAR; PG8_SCHED;
            PG8_LDB(B1, 0, 1); PG8_STAGE(PG8_SB(0, 0), b2, voffB);
            PG8_BAR; PG8_WAIT_L(0); PG8_MMA(0, 1, At, B1); PG8_BAR;
            PG8_LDA(At, 0, 1); PG8_STAGE(PG8_SA(0, 0), a2, voffA);
            PG8_BAR; PG8_WAIT_L(0); PG8_MMA(1, 0, At, B0); PG8_BAR; PG8_SCHED;
            PG8_STAGE(PG8_SB(0, 1), b2 + hstep, voffB);
            PG8_WAIT_V(6); PG8_BAR; PG8_MMA(1, 1, At, B1); PG8_BAR;
            PG8_LDB(B0, 1, 0); PG8_SCHED; PG8_LDA(At, 1, 0); PG8_STAGE(PG8_SA(0, 1), a2 + hstep, voffA);
            PG8_WAIT_L(8); PG8_BAR; PG8_WAIT_L(0); PG8_MMA(0, 0, At, B0); PG8_BAR; PG8_SCHED;
            PG8_LDB(B1, 1, 1); PG8_STAGE(PG8_SB(1, 0), b3, voffB);
            PG8_BAR; PG8_WAIT_L(0); PG8_MMA(0, 1, At, B1); PG8_BAR;
            PG8_LDA(At, 1, 1); PG8_STAGE(PG8_SA(1, 0), a3, voffA);
            PG8_BAR; PG8_WAIT_L(0); PG8_MMA(1, 0, At, B0); PG8_BAR; PG8_SCHED;
            PG8_STAGE(PG8_SB(1, 1), b3 + hstep, voffB);
            PG8_WAIT_V(6); PG8_BAR; PG8_MMA(1, 1, At, B1); PG8_BAR;
            }
        }
        if constexpr (ALIGN_EPI) { if (wr == 0) PG8_BAR; }
        if constexpr (!Epi::AFTER_DRAIN) { E(acc, cur, wr, wc, fr, fq); S.done(cur); }
        if (!has_next) break;
#pragma unroll
        for (int a = 0; a < 2; ++a)
#pragma unroll
            for (int b = 0; b < 2; ++b)
#pragma unroll
                for (int m = 0; m < 4; ++m)
#pragma unroll
                    for (int n = 0; n < 2; ++n) acc[a][b][m][n] = (f32x4){0.f, 0.f, 0.f, 0.f};
        cur = nxt; cA = nA; cB = nB; ++ui;
        if constexpr (ALIGN_EPI) { if (wr == 1) PG8_BAR; }
    }
    PG8_WAIT_V(0);
    if constexpr (!ALIGN_EPI) { if (wr == 0) PG8_BAR; }
    PG8_BAR;
    if constexpr (Epi::AFTER_DRAIN) { E.fused(acc, cur, wr, wc, fr, fq, lds, wid, lane); S.done(cur); }
#undef PG8_SA
#undef PG8_SB
#undef PG8_STAGE
#undef PG8_LDA
#undef PG8_LDB
#undef PG8_MMA
#undef PG8_WAIT_V
#undef PG8_WAIT_L
#undef PG8_BAR
#undef PG8_SCHED
}
}

#define GAS __attribute__((address_space(1)))
#define LAS __attribute__((address_space(3)))
typedef unsigned short bf16;
typedef float f32x4 __attribute__((ext_vector_type(4)));
typedef float f32x16 __attribute__((ext_vector_type(16)));
typedef short bf16x8 __attribute__((ext_vector_type(8)));
typedef short v4i16_t __attribute__((ext_vector_type(4)));
typedef unsigned u32x4 __attribute__((ext_vector_type(4)));
typedef unsigned u32x2 __attribute__((ext_vector_type(2)));

constexpr int DM = 1024, NB = 8, SEQ = 2048, DB = 32, DS = 16, PAST = 1024, DC = 512, DA = 512, NH = 8, HD = 64, CW = 31, DFF = 2816, INC = 2568;
constexpr int MP = NB * SEQ, MS = DB * DS, MT = MP + MS;
constexpr int NIN = 2560, NGU = 2 * DFF, SKV = PAST + DS;
constexpr int NMODB = NB + DB;
constexpr int MOD_SH1 = 0, MOD_SC1 = 1024, MOD_G1 = 2048, MOD_SH2 = 3072, MOD_SC2 = 4096, MOD_G2 = 5120;
constexpr float EPS = 1e-6f, LOG2E = 1.4426950408889634f, QSCALE = 0.125f * 1.4426950408889634f, NEG_BIG = -1e30f;
constexpr size_t OFF_YP = 0, OFF_YS = OFF_YP + (size_t)MP * DM, OFF_KP = OFF_YS + (size_t)MS * DM, OFF_VP = OFF_KP + (size_t)MP * DA, OFF_LP = OFF_VP + (size_t)MP * DA,
                 OFF_CP = OFF_LP + (size_t)MP * NH, OFF_KS = OFF_CP + (size_t)NB * 30 * DC, OFF_VS = OFF_KS + (size_t)MS * DA, OFF_LS = OFF_VS + (size_t)MS * DA,
                 OFF_CS = OFF_LS + (size_t)MS * NH, OUT_TOTAL = OFF_CS + (size_t)DB * 30 * DC;
constexpr size_t MiB = 1u << 20;
constexpr size_t WS_MOD = 0;
constexpr size_t WS_CUMP = 1 * MiB;
constexpr size_t WS_CUMS = 2 * MiB;
constexpr size_t WS_WIN = 4 * MiB, WS_WOUT = 9 * MiB, WS_WGU = 11 * MiB, WS_WDN = 22 * MiB;
constexpr size_t WS_H = 28 * MiB;
constexpr size_t WS_X1 = 61 * MiB;
constexpr size_t WS_U = 127 * MiB;
constexpr size_t WS_Q = 160 * MiB, WS_K = WS_Q + 16 * MiB + MiB / 2, WS_V = WS_K + 16 * MiB + MiB / 2;
constexpr size_t WS_MIX = 210 * MiB;
constexpr size_t WS_ACT = 127 * MiB;
constexpr size_t WS_END = 243 * MiB;
constexpr size_t WS_SLAB4 = WS_U;
constexpr size_t WS_SLAB7 = WS_H;
static_assert(WS_V + (size_t)MT * DA * 2 <= WS_MIX && WS_ACT + (size_t)MT * DFF * 2 <= WS_END && WS_MIX + (size_t)MT * DM * 2 <= WS_END, "ws map");
constexpr int LDS_BYTES = 147456;
constexpr int LDS_AUX = 131072;

#define LDS_WAIT() asm volatile("s_waitcnt lgkmcnt(0)" ::: "memory")
__device__ __forceinline__ unsigned f2bf(float f) { unsigned u = __builtin_bit_cast(unsigned, f); return (u + 0x7fffu + ((u >> 16) & 1u)) >> 16; }
typedef float f32x2_t __attribute__((ext_vector_type(2))); typedef __bf16 bf16x2_t __attribute__((ext_vector_type(2)));
__device__ __forceinline__ unsigned pk2(float lo, float hi) { f32x2_t v = {lo, hi}; bf16x2_t b = __builtin_convertvector(v, bf16x2_t); return __builtin_bit_cast(unsigned, b); }
__device__ __forceinline__ float wave_sum(float v) {
#pragma unroll
    for (int o = 1; o < 64; o <<= 1) v += __shfl_xor(v, o);
    return v;
}
__device__ __forceinline__ float sigmoidf_(float x) { return __builtin_amdgcn_rcpf(1.0f + __expf(-x)); }

struct Params {
    const float* in[24];
    float* out;
    unsigned char* ws;
    int ph_lo, ph_hi;
};

struct EpiIn {
    static constexpr bool PERM = false, AFTER_DRAIN = false;
    float* u; bf16* qkv; float* out; const float* qg; long kg_minus_qg;
    __device__ __forceinline__ void operator()(const pg8::f32x4 (&acc)[2][2][4][2], const pg8::Unit& un, int wr, int wc, int fr, int fq) const {
        const int row0 = un.pm * 256 + wr * 64 + fr, pn = un.pn;
        if (pn < 4) {
            const bool samp = un.pm >= MP / 256, tailp = (un.pm & 7) == 7;
#pragma unroll
            for (int ai = 0; ai < 2; ++ai)
#pragma unroll
                for (int m = 0; m < 4; ++m) {
                    const int row = row0 + ai * 128 + m * 16, col = pn * 128 + wc * 32 + 4 * fq;
                    bf16* rp = (bf16*)u + (size_t)row * DC + col;
                    float* cp = nullptr;
                    if (samp) { const int rr = row - MP; cp = out + OFF_CS + ((size_t)(rr >> 4) * 30 + (30 - DS) + (rr & 15)) * DC + col; }
                    else if (tailp && (row & (SEQ - 1)) >= SEQ - 30) cp = out + OFF_CP + ((size_t)(row >> 11) * 30 + ((row & (SEQ - 1)) - (SEQ - 30))) * DC + col;
#pragma unroll
                    for (int n = 0; n < 2; ++n) { const f32x4 a = acc[ai][0][m][n], g = acc[ai][1][m][n]; f32x4 r;
#pragma unroll
                        for (int j = 0; j < 4; ++j) r[j] = a[j] * sigmoidf_(g[j]);
                        u32x2 w; w.x = pk2(r[0], r[1]); w.y = pk2(r[2], r[3]);
                        *(u32x2*)(rp + n * 16) = w;
                        if (cp) *(f32x4*)(cp + n * 16) = r; }
                }
        } else {
            const int t = (pn - 4) >> 1, head = 4 * ((pn - 4) & 1) + wc;
            const float* gsrc = qg + (t == 0 ? 0L : kg_minus_qg);
            const float gs = (t == 0) ? QSCALE : 1.f;
            f32x4 gam00 = *(const f32x4*)(gsrc + head * 64 + 4 * fq) * gs, gam01 = *(const f32x4*)(gsrc + head * 64 + 16 + 4 * fq) * gs,
                  gam10 = *(const f32x4*)(gsrc + head * 64 + 32 + 4 * fq) * gs, gam11 = *(const f32x4*)(gsrc + head * 64 + 48 + 4 * fq) * gs;
            if (t == 2) { gam00 = (f32x4){1.f, 1.f, 1.f, 1.f}; gam01 = gam00; gam10 = gam00; gam11 = gam00; }
            bf16* bdst = qkv + (size_t)t * ((WS_K - WS_Q) / 2);
            const bool prompt = un.pm < (MP / 256);
            float* fbase = out + (t == 1 ? (prompt ? OFF_KP : OFF_KS) : (prompt ? OFF_VP : OFF_VS));
#pragma unroll
            for (int ai = 0; ai < 2; ++ai)
#pragma unroll
                for (int m = 0; m < 4; ++m) {
                    const int row = row0 + ai * 128 + m * 16;
                    float rstd = 1.f;
                    if (t < 2) { float ss = 0.f;
#pragma unroll
                        for (int bj = 0; bj < 2; ++bj)
#pragma unroll
                            for (int n = 0; n < 2; ++n) { const f32x4 x = acc[ai][bj][m][n]; ss += (x[0] * x[0] + x[1] * x[1]) + (x[2] * x[2] + x[3] * x[3]); }
                        ss += __shfl_xor(ss, 16); ss += __shfl_xor(ss, 32);
                        rstd = rsqrtf(ss * (1.0f / 64.0f) + EPS); }
                    const size_t frow = (size_t)(prompt ? row : row - MP) * DA + head * 64 + 4 * fq;
                    bf16* bp = bdst + (size_t)row * DA + head * 64 + 4 * fq;
#pragma unroll
                    for (int bj = 0; bj < 2; ++bj)
#pragma unroll
                        for (int n = 0; n < 2; ++n) { f32x4 v = acc[ai][bj][m][n] * rstd * (bj == 0 ? (n == 0 ? gam00 : gam01) : (n == 0 ? gam10 : gam11));
                            if (t > 0) *(f32x4*)(fbase + frow + 32 * bj + 16 * n) = v;
                            u32x2 w; w.x = pk2(v[0], v[1]); w.y = pk2(v[2], v[3]);
                            *(u32x2*)(bp + 32 * bj + 16 * n) = w; }
                }
        }
    }
};
__device__ __forceinline__ int mod_row_of(int row) { return row < MP ? (row >> 11) : NB + ((row - MP) >> 4); }
template <bool DST_BF16, bool BASE_BF16> struct EpiRes {
    static constexpr bool PERM = false, AFTER_DRAIN = false;
    const float* base_p; const float* base_s; float* dst_p; float* dst_s; const float* gate;
    __device__ __forceinline__ void operator()(const pg8::f32x4 (&acc)[2][2][4][2], const pg8::Unit& un, int wr, int wc, int fr, int fq) const {
        const int row0 = un.pm * 256 + wr * 64 + fr, col0 = un.pn * 256 + wc * 32 + 4 * fq;
        const float* gp = gate + (size_t)(un.pm >> 3) * 6144 + col0;
        f32x4 gv[4];
#pragma unroll
        for (int q = 0; q < 4; ++q) gv[q] = *(const f32x4*)(gp + (q >> 1) * 128 + (q & 1) * 16);
#pragma unroll
        for (int ai = 0; ai < 2; ++ai) {
            f32x4 bv[4][4];
#pragma unroll
            for (int m = 0; m < 4; ++m)
#pragma unroll
                for (int q = 0; q < 4; ++q) { const size_t o = (size_t)(row0 + ai * 128 + m * 16) * DM + col0 + (q >> 1) * 128 + (q & 1) * 16;
                    if (BASE_BF16) { const u32x2 w = *(const u32x2*)((const bf16*)base_p + o); bv[m][q] = (f32x4){__uint_as_float(w.x << 16), __uint_as_float(w.x & 0xffff0000u), __uint_as_float(w.y << 16), __uint_as_float(w.y & 0xffff0000u)}; }
                    else bv[m][q] = *(const f32x4*)(base_p + o); }
#pragma unroll
            for (int m = 0; m < 4; ++m)
#pragma unroll
                for (int q = 0; q < 4; ++q) { const size_t o = (size_t)(row0 + ai * 128 + m * 16) * DM + col0 + (q >> 1) * 128 + (q & 1) * 16; const f32x4 r = bv[m][q] + gv[q] * acc[ai][q >> 1][m][q & 1];
                    if (DST_BF16) { u32x2 w; w.x = pk2(r[0], r[1]); w.y = pk2(r[2], r[3]); *(u32x2*)((bf16*)dst_p + o) = w; } else *(f32x4*)(dst_p + o) = r; }
        }
    }
};
struct ResOrder {
    pg8::StaticOrder so; int nsub, ksub;
    __device__ __forceinline__ bool next(int i, pg8::Unit& u) const {
        const long L = (long)i * so.G + so.c; if (L < so.nwg) return so.next(i, u);
        const int s = (int)(L - so.nwg); if (s >= nsub) return false;
        u.pm = MP / 256 + (s & 1); u.pn = (s >> 1) & 3; u.koff = (s >> 3) * ksub; u.nt = ksub / 64; return true; }
    __device__ __forceinline__ void a_ready(const pg8::Unit&) const {}
    __device__ __forceinline__ void done(const pg8::Unit&) const {}
};
struct EpiSlab {
    static constexpr bool PERM = false, AFTER_DRAIN = false;
    float* slab;
    __device__ __forceinline__ void operator()(const pg8::f32x4 (&acc)[2][2][4][2], const pg8::Unit& un, int wr, int wc, int fr, int fq) const {
        const int row0 = un.pm * 256 + wr * 64 + fr - MP, col0 = un.pn * 256 + wc * 32 + 4 * fq;
        float* sp = slab + (size_t)(un.koff >> 8) * MS * DM;
#pragma unroll
        for (int ai = 0; ai < 2; ++ai)
#pragma unroll
            for (int m = 0; m < 4; ++m) { float* dp = sp + (size_t)(row0 + ai * 128 + m * 16) * DM + col0;
#pragma unroll
                for (int bj = 0; bj < 2; ++bj)
#pragma unroll
                    for (int n = 0; n < 2; ++n) *(f32x4*)(dp + bj * 128 + n * 16) = acc[ai][bj][m][n]; }
    }
};
template <bool DST_BF16, bool BASE_BF16> struct EpiRes2 {
    static constexpr bool PERM = false, AFTER_DRAIN = false;
    EpiRes<DST_BF16, BASE_BF16> res; EpiSlab slab;
    __device__ __forceinline__ void operator()(const pg8::f32x4 (&acc)[2][2][4][2], const pg8::Unit& un, int wr, int wc, int fr, int fq) const {
        if (un.pm < MP / 256) res(acc, un, wr, wc, fr, fq); else slab(acc, un, wr, wc, fr, fq); }
};
struct EpiGU {
    static constexpr bool PERM = false, AFTER_DRAIN = false;
    bf16* act;
    __device__ __forceinline__ void operator()(const pg8::f32x4 (&acc)[2][2][4][2], const pg8::Unit& un, int wr, int wc, int fr, int fq) const {
        const int row0 = un.pm * 256 + wr * 64 + fr;
#pragma unroll
        for (int ai = 0; ai < 2; ++ai)
#pragma unroll
            for (int m = 0; m < 4; ++m) {
                bf16* rp = act + (size_t)(row0 + ai * 128 + m * 16) * DFF + un.pn * 128 + wc * 32 + 4 * fq;
#pragma unroll
                for (int n = 0; n < 2; ++n) { const f32x4 g = acc[ai][0][m][n], up = acc[ai][1][m][n]; float r[4];
#pragma unroll
                    for (int j = 0; j < 4; ++j) r[j] = g[j] * sigmoidf_(g[j]) * up[j];
                    u32x2 w; w.x = pk2(r[0], r[1]); w.y = pk2(r[2], r[3]);
                    *(u32x2*)(rp + n * 16) = w; }
            }
    }
};

__device__ __forceinline__ void p0_transpose_item(const float* W, int ldw, int K, bf16* WT, int dest_row0, int k0, int n0, LAS float* scr, int lane) {
    { f32x4 wv4[8];
#pragma unroll
        for (int i = 0; i < 8; ++i) wv4[i] = *(const f32x4*)(W + (size_t)(k0 + 8 * i + (lane >> 3)) * ldw + n0 + 4 * (lane & 7));
#pragma unroll
        for (int i = 0; i < 8; ++i) { LAS float* d = scr + (8 * i + (lane >> 3)) * 33 + 4 * (lane & 7); d[0] = wv4[i][0]; d[1] = wv4[i][1]; d[2] = wv4[i][2]; d[3] = wv4[i][3]; } }
    LDS_WAIT();
    const int c = lane & 7;
#pragma unroll
    for (int j = 0; j < 4; ++j) { const int n = (lane >> 3) + 8 * j; const LAS float* s = scr + (8 * c) * 33 + n;
        u32x4 o; o.x = pk2(s[0 * 33], s[1 * 33]); o.y = pk2(s[2 * 33], s[3 * 33]); o.z = pk2(s[4 * 33], s[5 * 33]); o.w = pk2(s[6 * 33], s[7 * 33]);
        *(u32x4*)(WT + (size_t)(dest_row0 + n) * K + k0 + 8 * c) = o; }
    LDS_WAIT();
}
__device__ __forceinline__ int win_dest(int n0) {
    if (n0 < 512) return 256 * (n0 >> 7) + (n0 & 127);
    if (n0 < 1024) { const int j = n0 - 512; return 256 * (j >> 7) + 128 + (j & 127); }
    const int c = n0 - 1024, t = c >> 9, cc = c & 511, hh = cc >> 6, d = cc & 63;
    return 256 * (4 + 2 * t + (hh >> 2)) + 128 * (d >> 5) + 32 * (hh & 3);
}
__device__ __forceinline__ void p0_phase(const Params& P, LAS unsigned char* lds) {
    const int tid = threadIdx.x, lane = tid & 63, wave = __builtin_amdgcn_readfirstlane(tid >> 6);
    float* mod = (float*)(P.ws + WS_MOD);
    for (int it = blockIdx.x; it < 192; it += gridDim.x) {
        const int n0 = it * 32, c = lane & 31, kp = lane >> 5;
        f32x16 ac0, ac1;
#pragma unroll
        for (int r = 0; r < 16; ++r) { ac0[r] = 0.f; ac1[r] = 0.f; }
        LAS float* sl = (LAS float*)lds;
        for (int half = 0; half < 2; ++half) {
            float wreg[32];
            const float* wp = P.in[8] + (size_t)(half * 512 + wave * 64 + kp) * 6144 + n0 + c;
#pragma unroll
            for (int i = 0; i < 32; ++i) wreg[i] = wp[(size_t)(2 * i) * 6144];
            f32x4 cr[10];
#pragma unroll
            for (int j = 0; j < 10; ++j) { const int bb = 4 * j + (tid >> 7), k4 = tid & 127;
                cr[j] = (j < 2) ? *(const f32x4*)(P.in[6] + (size_t)bb * DM + half * 512 + 4 * k4) : *(const f32x4*)(P.in[7] + (size_t)(bb - NB) * DM + half * 512 + 4 * k4); }
            __syncthreads();
            typedef float f32x2w __attribute__((ext_vector_type(2)));
#pragma unroll
            for (int j = 0; j < 10; ++j) { const int bb = 4 * j + (tid >> 7), k4 = tid & 127;
                *(LAS f32x2w*)(sl + bb * 512 + 2 * k4) = (f32x2w){cr[j][0], cr[j][2]}; *(LAS f32x2w*)(sl + bb * 512 + 256 + 2 * k4) = (f32x2w){cr[j][1], cr[j][3]}; }
            __syncthreads();
#pragma unroll 4
            for (int i = 0; i < NMODB; ++i) { const float x = sl[tid + 512 * i]; sl[tid + 512 * i] = x * sigmoidf_(x); }
            __syncthreads();
            const int bl = lane & 31, bl1 = (32 + bl < NMODB) ? 32 + bl : NMODB - 1;
            const LAS float* sb0 = sl + bl * 512 + kp * 256 + wave * 32;
            const LAS float* sb1 = sl + bl1 * 512 + kp * 256 + wave * 32;
#pragma unroll
            for (int blk = 0; blk < 4; ++blk) {
                u32x4 aw; aw.x = pk2(wreg[8 * blk], wreg[8 * blk + 1]); aw.y = pk2(wreg[8 * blk + 2], wreg[8 * blk + 3]); aw.z = pk2(wreg[8 * blk + 4], wreg[8 * blk + 5]); aw.w = pk2(wreg[8 * blk + 6], wreg[8 * blk + 7]);
                const f32x4 x0 = *(const LAS f32x4*)(sb0 + 8 * blk), x1 = *(const LAS f32x4*)(sb0 + 8 * blk + 4), y0 = *(const LAS f32x4*)(sb1 + 8 * blk), y1 = *(const LAS f32x4*)(sb1 + 8 * blk + 4);
                u32x4 b0, b1; b0.x = pk2(x0[0], x0[1]); b0.y = pk2(x0[2], x0[3]); b0.z = pk2(x1[0], x1[1]); b0.w = pk2(x1[2], x1[3]);
                b1.x = pk2(y0[0], y0[1]); b1.y = pk2(y0[2], y0[3]); b1.z = pk2(y1[0], y1[1]); b1.w = pk2(y1[2], y1[3]);
                ac0 = __builtin_amdgcn_mfma_f32_32x32x16_bf16(__builtin_bit_cast(bf16x8, aw), __builtin_bit_cast(bf16x8, b0), ac0, 0, 0, 0);
                ac1 = __builtin_amdgcn_mfma_f32_32x32x16_bf16(__builtin_bit_cast(bf16x8, aw), __builtin_bit_cast(bf16x8, b1), ac1, 0, 0, 0);
            }
        }
        __syncthreads();
        LAS float* red = (LAS float*)lds;
#pragma unroll
        for (int r = 0; r < 16; ++r) { const int ci = (r & 3) + 8 * (r >> 2) + 4 * kp, bq = lane & 31;
            red[(wave * NMODB + bq) * 32 + ci] = ac0[r]; if (bq < NMODB - 32) red[(wave * NMODB + 32 + bq) * 32 + ci] = ac1[r]; }
        __syncthreads();
        for (int o = tid; o < NMODB * 32; o += 512) { const int b = o >> 5, l = o & 31; float sum = P.in[9][n0 + l];
#pragma unroll
            for (int w = 0; w < 8; ++w) sum += red[(w * NMODB + b) * 32 + l];
            mod[(size_t)b * 6144 + n0 + l] = sum; }
        __syncthreads();
    }
}
constexpr int I_IN = 16 * 80, I_OUT = 16 * 32, I_G = 16 * 88, I_D = 44 * 32, NITEMS = I_IN + I_OUT + 2 * I_G + I_D;
__device__ __forceinline__ void convert_items(const Params& P, LAS unsigned char* lds, int it0, int it1, int worker, int nworkers) {
    const int lane = threadIdx.x & 63, wave = __builtin_amdgcn_readfirstlane(threadIdx.x >> 6);
    LAS float* scr = (LAS float*)(lds + wave * 16384);
    for (int it = it0 + worker; it < it1; it += nworkers) {
        int r = it;
        if (r < I_IN) { const int kb = r / 80, nb = r % 80; p0_transpose_item(P.in[11], INC, DM, (bf16*)(P.ws + WS_WIN), win_dest(32 * nb), 64 * kb, 32 * nb, scr, lane); continue; } r -= I_IN;
        if (r < I_OUT) { const int kb = r / 32, nb = r % 32; p0_transpose_item(P.in[19], DM, DM, (bf16*)(P.ws + WS_WOUT), 32 * nb, 64 * kb, 32 * nb, scr, lane); continue; } r -= I_OUT;
        if (r < I_G) { const int kb = r / 88, nb = r % 88, n0 = 32 * nb; p0_transpose_item(P.in[21], DFF, DM, (bf16*)(P.ws + WS_WGU), 256 * (n0 >> 7) + (n0 & 127), 64 * kb, n0, scr, lane); continue; } r -= I_G;
        if (r < I_G) { const int kb = r / 88, nb = r % 88, n0 = 32 * nb; p0_transpose_item(P.in[22], DFF, DM, (bf16*)(P.ws + WS_WGU), 256 * (n0 >> 7) + 128 + (n0 & 127), 64 * kb, n0, scr, lane); continue; } r -= I_G;
        { const int kb = r / 32, nb = r % 32; p0_transpose_item(P.in[23], DM, DFF, (bf16*)(P.ws + WS_WDN), 32 * nb, 64 * kb, 32 * nb, scr, lane); }
    }
}

template <bool SLAB4>
__device__ __forceinline__ void norm_load_row(const float* xp, const float* xs, const float* slab, const float* g1mod, int row, int lane, f32x4 (&d)[4]) {
    if (SLAB4 && row < MP) { const bf16* xr = (const bf16*)xp + (size_t)row * DM;
#pragma unroll
        for (int j = 0; j < 4; ++j) { const u32x2 w = *(const u32x2*)(xr + 256 * j + 4 * lane); d[j] = (f32x4){__uint_as_float(w.x << 16), __uint_as_float(w.x & 0xffff0000u), __uint_as_float(w.y << 16), __uint_as_float(w.y & 0xffff0000u)}; }
    } else if (!SLAB4) { const float* xr = (row < MP) ? xp + (size_t)row * DM : xs + (size_t)(row - MP) * DM;
#pragma unroll
        for (int j = 0; j < 4; ++j) d[j] = *(const f32x4*)(xr + 256 * j + 4 * lane);
    } else { const int r = row - MP; const float* gp = g1mod + (size_t)mod_row_of(row) * 6144;
        f32x4 q0[4], q1[4], q2[4], q3[4], xr4[4], gg[4];
#pragma unroll
        for (int j = 0; j < 4; ++j) { const int c = 256 * j + 4 * lane; const float* sp = slab + (size_t)r * DM + c;
            q0[j] = *(const f32x4*)sp; q1[j] = *(const f32x4*)(sp + (size_t)MS * DM); q2[j] = *(const f32x4*)(sp + (size_t)2 * MS * DM); q3[j] = *(const f32x4*)(sp + (size_t)3 * MS * DM);
            xr4[j] = *(const f32x4*)(xs + (size_t)r * DM + c); gg[j] = *(const f32x4*)(gp + c); }
#pragma unroll
        for (int j = 0; j < 4; ++j) d[j] = xr4[j] + gg[j] * ((q0[j] + q1[j]) + (q2[j] + q3[j]));
    }
}
template <bool WITH_F, bool SLAB4>
__device__ __forceinline__ void norm_phase(const Params& P, LAS unsigned char* lds, const float* xp, const float* xs, const float* gain, int off_sh, int off_sc, const float* slab, const float* g1mod, float* x1s) {
    const int tid = threadIdx.x, lane = tid & 63, wave = __builtin_amdgcn_readfirstlane(tid >> 6);
    const float* mod = (const float*)(P.ws + WS_MOD);
    bf16* hout = (bf16*)(P.ws + WS_H);
    LAS float* wf = (LAS float*)lds;
    const int gw = blockIdx.x * 8 + wave, NGW = gridDim.x * 8;
    const float bfv = WITH_F ? P.in[12][lane >> 3] : 0.f;
    f32x4 gn[4];
#pragma unroll
    for (int j = 0; j < 4; ++j) gn[j] = *(const f32x4*)(gain + 256 * j + 4 * lane);
    f32x4 bA[4], bB[4];
    if (gw < MT) norm_load_row<SLAB4>(xp, xs, slab, g1mod, gw, lane, bA);
    if (gw + NGW < MT) norm_load_row<SLAB4>(xp, xs, slab, g1mod, gw + NGW, lane, bB);
    if (WITH_F) {
#pragma unroll
        for (int e = tid; e < DM * 2; e += 512) { const int k = e >> 1, hh = e & 1; *(LAS f32x4*)(wf + hh * 4096 + ((((k & 3) * 4 + (k >> 8)) * 64 + ((k & 255) >> 2)) * 4)) = *(const f32x4*)(P.in[11] + (size_t)k * INC + NIN + hh * 4); }
        __syncthreads();
    }
    for (int row0 = gw; row0 < MT; row0 += 2 * NGW) {
#pragma unroll
      for (int hh = 0; hh < 2; ++hh) {
        const int row = row0 + hh * NGW;
        if (row < MT) {
        f32x4 v[4];
#pragma unroll
        for (int j = 0; j < 4; ++j) v[j] = hh ? bB[j] : bA[j];
        const float* mr = mod + (size_t)mod_row_of(row) * 6144;
        f32x4 scv[4], shv[4];
#pragma unroll
        for (int j = 0; j < 4; ++j) { scv[j] = *(const f32x4*)(mr + off_sc + 256 * j + 4 * lane); shv[j] = *(const f32x4*)(mr + off_sh + 256 * j + 4 * lane); }
        __builtin_amdgcn_sched_barrier(0);
        { const int nrow = row + 2 * NGW; if (nrow < MT) { if (hh) norm_load_row<SLAB4>(xp, xs, slab, g1mod, nrow, lane, bB); else norm_load_row<SLAB4>(xp, xs, slab, g1mod, nrow, lane, bA); } }
        __builtin_amdgcn_sched_barrier(0);
        float ss = 0.f;
#pragma unroll
        for (int j = 0; j < 4; ++j) { if (SLAB4 && row >= MP) *(f32x4*)(x1s + (size_t)(row - MP) * DM + 256 * j + 4 * lane) = v[j]; ss += (v[j][0] * v[j][0] + v[j][1] * v[j][1]) + (v[j][2] * v[j][2] + v[j][3] * v[j][3]); }
        const float rstd = rsqrtf(wave_sum(ss) * (1.0f / DM) + EPS);
        float f[8];
#pragma unroll
        for (int q = 0; q < 8; ++q) f[q] = 0.f;
#pragma unroll
        for (int j = 0; j < 4; ++j) { const int c = 256 * j + 4 * lane;
            const f32x4 g = gn[j], sc = scv[j], sh = shv[j];
            const f32x4 h = v[j] * rstd * g * (sc + 1.0f) + sh;
            u32x2 w; w.x = pk2(h[0], h[1]); w.y = pk2(h[2], h[3]);
            *(u32x2*)(hout + (size_t)row * DM + c) = w;
            if (WITH_F) {
#pragma unroll
                for (int e = 0; e < 4; ++e) { const f32x4 a = *(const LAS f32x4*)(wf + ((e * 4 + j) * 64 + lane) * 4), b = *(const LAS f32x4*)(wf + 4096 + ((e * 4 + j) * 64 + lane) * 4);
                    f[0] += h[e] * a[0]; f[1] += h[e] * a[1]; f[2] += h[e] * a[2]; f[3] += h[e] * a[3]; f[4] += h[e] * b[0]; f[5] += h[e] * b[1]; f[6] += h[e] * b[2]; f[7] += h[e] * b[3]; }
            }
        }
        if (WITH_F) {
            const bool b5 = (lane & 32) != 0, b4 = (lane & 16) != 0, b3 = (lane & 8) != 0;
            float g4[4], h2[2];
#pragma unroll
            for (int q = 0; q < 4; ++q) { const float snd = b5 ? f[q] : f[q + 4], kp = b5 ? f[q + 4] : f[q]; g4[q] = kp + __shfl_xor(snd, 32); }
#pragma unroll
            for (int q = 0; q < 2; ++q) { const float snd = b4 ? g4[q] : g4[q + 2], kp = b4 ? g4[q + 2] : g4[q]; h2[q] = kp + __shfl_xor(snd, 16); }
            float z; { const float snd = b3 ? h2[0] : h2[1], kp = b3 ? h2[1] : h2[0]; z = kp + __shfl_xor(snd, 8); }
            z += __shfl_xor(z, 4); z += __shfl_xor(z, 2); z += __shfl_xor(z, 1);
            if ((lane & 7) == 0) { const int hq = lane >> 3; z += bfv;
                const float lf = fminf(z, 0.f) - log1pf(__expf(-fabsf(z)));
                float* lo = (row < MP) ? P.out + OFF_LP + (size_t)row * NH : P.out + OFF_LS + (size_t)(row - MP) * NH;
                lo[hq] = lf; }
        }
        }
      }
    }
}

__device__ __forceinline__ void cumsum_items(const Params& P) {
    const int tid = threadIdx.x, lane = tid & 63, wave = __builtin_amdgcn_readfirstlane(tid >> 6);
    if (wave != 0) return;
    float* cump = (float*)(P.ws + WS_CUMP); float* cums = (float*)(P.ws + WS_CUMS);
    for (int it = (int)gridDim.x - 1 - (int)blockIdx.x; it < NB + DB; it += gridDim.x) {
        if (it < NB) {
            const int b = it; const float* src = P.out + OFF_LP + ((size_t)b * SEQ + 32 * lane) * NH;
            float tot[8];
#pragma unroll
            for (int h = 0; h < 8; ++h) tot[h] = 0.f;
#pragma unroll 16
            for (int t = 0; t < 32; ++t) { const f32x4 a = *(const f32x4*)(src + t * 8), c = *(const f32x4*)(src + t * 8 + 4);
                tot[0] += a[0]; tot[1] += a[1]; tot[2] += a[2]; tot[3] += a[3]; tot[4] += c[0]; tot[5] += c[1]; tot[6] += c[2]; tot[7] += c[3]; }
            float run[8];
#pragma unroll
            for (int h = 0; h < 8; ++h) { float s = tot[h];
#pragma unroll
                for (int o = 1; o < 64; o <<= 1) { const float y = __shfl_up(s, o); if (lane >= o) s += y; }
                run[h] = s - tot[h]; }
#pragma unroll 2
            for (int t4 = 0; t4 < 32; t4 += 4) {
                f32x4 o[8];
#pragma unroll
                for (int e = 0; e < 4; ++e) { const f32x4 a = *(const f32x4*)(src + (t4 + e) * 8), c = *(const f32x4*)(src + (t4 + e) * 8 + 4);
                    run[0] += a[0]; run[1] += a[1]; run[2] += a[2]; run[3] += a[3]; run[4] += c[0]; run[5] += c[1]; run[6] += c[2]; run[7] += c[3];
#pragma unroll
                    for (int h = 0; h < 8; ++h) o[h][e] = run[h] * LOG2E; }
#pragma unroll
                for (int h = 0; h < 8; ++h) *(f32x4*)(cump + ((size_t)(b * NH + h)) * SEQ + 32 * lane + t4) = o[h];
            }
        } else {
            const int b = it - NB; const float* src = P.in[4] + ((size_t)b * PAST + 16 * lane) * NH;
            float tot[8];
#pragma unroll
            for (int h = 0; h < 8; ++h) tot[h] = 0.f;
#pragma unroll
            for (int t = 0; t < 16; ++t) { const f32x4 a = *(const f32x4*)(src + t * 8), c = *(const f32x4*)(src + t * 8 + 4);
                tot[0] += a[0]; tot[1] += a[1]; tot[2] += a[2]; tot[3] += a[3]; tot[4] += c[0]; tot[5] += c[1]; tot[6] += c[2]; tot[7] += c[3]; }
            float run[8], all[8];
#pragma unroll
            for (int h = 0; h < 8; ++h) { float s = tot[h];
#pragma unroll
                for (int o = 1; o < 64; o <<= 1) { const float y = __shfl_up(s, o); if (lane >= o) s += y; }
                run[h] = s - tot[h]; all[h] = __shfl(s, 63); }
#pragma unroll 2
            for (int t4 = 0; t4 < 16; t4 += 4) {
                f32x4 o[8];
#pragma unroll
                for (int e = 0; e < 4; ++e) { const f32x4 a = *(const f32x4*)(src + (t4 + e) * 8), c = *(const f32x4*)(src + (t4 + e) * 8 + 4);
                    run[0] += a[0]; run[1] += a[1]; run[2] += a[2]; run[3] += a[3]; run[4] += c[0]; run[5] += c[1]; run[6] += c[2]; run[7] += c[3];
#pragma unroll
                    for (int h = 0; h < 8; ++h) o[h][e] = run[h] * LOG2E; }
#pragma unroll
                for (int h = 0; h < 8; ++h) *(f32x4*)(cums + ((size_t)(b * NH + h)) * SKV + 16 * lane + t4) = o[h];
            }
            const float* ns = P.out + OFF_LS + (size_t)b * DS * NH;
            for (int t = 0; t < DS; ++t) { const f32x4 a = *(const f32x4*)(ns + t * 8), c = *(const f32x4*)(ns + t * 8 + 4);
                all[0] += a[0]; all[1] += a[1]; all[2] += a[2]; all[3] += a[3]; all[4] += c[0]; all[5] += c[1]; all[6] += c[2]; all[7] += c[3];
                if (lane == t) {
#pragma unroll
                    for (int h = 0; h < 8; ++h) cums[((size_t)(b * NH + h)) * SKV + PAST + t] = all[h] * LOG2E; } }
        }
    }
}

__device__ __forceinline__ int crow(int r, int hi) { return (r & 3) + 8 * (r >> 2) + 4 * hi; }
constexpr float ATT_THR = 16.0f;
__device__ __forceinline__ void attn_tile(const LAS unsigned char* Kt, const LAS unsigned char* Vt, const LAS float* ck, float& cqm, int kv0, int qpos, bool need_mask,
                                          const bf16x8 (&qf)[4], f32x16& o0, f32x16& o1, float& m_run, float& l_run, int lane) {
    const int r32 = lane & 31, hi = lane >> 5;
    bf16x8 kf[8];
#pragma unroll
    for (int d0 = 0; d0 < 4; ++d0) { kf[2 * d0] = *(const LAS bf16x8*)(Kt + (2 * d0 + hi) * 1024 + r32 * 16); kf[2 * d0 + 1] = *(const LAS bf16x8*)(Kt + (2 * d0 + hi) * 1024 + 512 + r32 * 16); }
    f32x16 p0, p1;
#pragma unroll
    for (int g = 0; g < 4; ++g) { const f32x4 c0 = *(const LAS f32x4*)(ck + 8 * g + 4 * hi), c1 = *(const LAS f32x4*)(ck + 32 + 8 * g + 4 * hi);
#pragma unroll
        for (int j = 0; j < 4; ++j) { p0[4 * g + j] = cqm - c0[j]; p1[4 * g + j] = cqm - c1[j]; } }
    __builtin_amdgcn_sched_barrier(0);
#pragma unroll
    for (int d0 = 0; d0 < 4; ++d0) {
        p0 = __builtin_amdgcn_mfma_f32_32x32x16_bf16(kf[2 * d0], qf[d0], p0, 0, 0, 0);
        p1 = __builtin_amdgcn_mfma_f32_32x32x16_bf16(kf[2 * d0 + 1], qf[d0], p1, 0, 0, 0);
    }
    const LAS unsigned char* vb = Vt + (4 * hi + ((lane & 15) >> 2)) * 64 + ((lane >> 4) & 1) * 32 + (lane & 3) * 8;
    v4i16_t vlo[8], vhi[8];
#pragma unroll
    for (int d0b = 0; d0b < 2; ++d0b)
#pragma unroll
        for (int sk = 0; sk < 4; ++sk) {
            vlo[d0b * 4 + sk] = __builtin_amdgcn_ds_read_tr16_b64_v4i16((LAS v4i16_t*)(vb + d0b * 4096 + sk * 1024));
            vhi[d0b * 4 + sk] = __builtin_amdgcn_ds_read_tr16_b64_v4i16((LAS v4i16_t*)(vb + d0b * 4096 + sk * 1024 + 512)); }
    __builtin_amdgcn_sched_barrier(0);
    if (need_mask) {
#pragma unroll
        for (int r = 0; r < 16; ++r) { const int kv = kv0 + crow(r, hi); if (kv > qpos) p0[r] = NEG_BIG; if (kv + 32 > qpos) p1[r] = NEG_BIG; }
    }
    float mxa = __builtin_fmaxf(__builtin_fmaxf(p0[0], p0[1]), p1[0]), mxb = __builtin_fmaxf(__builtin_fmaxf(p0[2], p0[3]), p1[1]);
    mxa = __builtin_fmaxf(__builtin_fmaxf(mxa, p1[2]), p1[3]);
#pragma unroll
    for (int r = 4; r < 16; r += 4) { mxa = __builtin_fmaxf(__builtin_fmaxf(mxa, p0[r]), p0[r + 1]); mxb = __builtin_fmaxf(__builtin_fmaxf(mxb, p0[r + 2]), p0[r + 3]);
        mxa = __builtin_fmaxf(__builtin_fmaxf(mxa, p1[r]), p1[r + 1]); mxb = __builtin_fmaxf(__builtin_fmaxf(mxb, p1[r + 2]), p1[r + 3]); }
    float mx = __builtin_fmaxf(mxa, mxb);
    { const auto rr = __builtin_amdgcn_permlane32_swap(__float_as_uint(mx), __float_as_uint(mx), false, false); mx = __builtin_fmaxf(__uint_as_float(rr[0]), __uint_as_float(rr[1])); }
    if (__any(mx > ATT_THR)) {
        const float d = (mx > ATT_THR) ? mx : 0.f, alpha = __builtin_amdgcn_exp2f(-d);
#pragma unroll
        for (int r = 0; r < 16; ++r) { p0[r] -= d; p1[r] -= d; }
        m_run += d; cqm -= d; l_run *= alpha; o0 *= alpha; o1 *= alpha;
    }
    float ls = 0.f;
#pragma unroll
    for (int r = 0; r < 16; ++r) { p0[r] = __builtin_amdgcn_exp2f(p0[r]); p1[r] = __builtin_amdgcn_exp2f(p1[r]); ls += p0[r] + p1[r]; }
    { const auto rr = __builtin_amdgcn_permlane32_swap(__float_as_uint(ls), __float_as_uint(ls), false, false); ls = __uint_as_float(rr[0]) + __uint_as_float(rr[1]); }
    l_run += ls;
    bf16x8 pf[4];
#pragma unroll
    for (int s = 0; s < 2; ++s) {
        u32x4 w0, w1;
        w0.x = pk2(p0[8 * s + 0], p0[8 * s + 1]); w0.y = pk2(p0[8 * s + 2], p0[8 * s + 3]); w0.z = pk2(p0[8 * s + 4], p0[8 * s + 5]); w0.w = pk2(p0[8 * s + 6], p0[8 * s + 7]);
        w1.x = pk2(p1[8 * s + 0], p1[8 * s + 1]); w1.y = pk2(p1[8 * s + 2], p1[8 * s + 3]); w1.z = pk2(p1[8 * s + 4], p1[8 * s + 5]); w1.w = pk2(p1[8 * s + 6], p1[8 * s + 7]);
        pf[s] = __builtin_bit_cast(bf16x8, w0); pf[2 + s] = __builtin_bit_cast(bf16x8, w1);
    }
    __builtin_amdgcn_sched_barrier(0);
#pragma unroll
    for (int d0b = 0; d0b < 2; ++d0b)
#pragma unroll
        for (int sk = 0; sk < 4; ++sk) {
            const v4i16_t lo = vlo[d0b * 4 + sk], hh = vhi[d0b * 4 + sk];
            const bf16x8 a = (bf16x8){lo[0], lo[1], lo[2], lo[3], hh[0], hh[1], hh[2], hh[3]};
            if (d0b == 0) o0 = __builtin_amdgcn_mfma_f32_32x32x16_bf16(a, pf[sk], o0, 0, 0, 0);
            else o1 = __builtin_amdgcn_mfma_f32_32x32x16_bf16(a, pf[sk], o1, 0, 0, 0);
        }
}

__device__ __forceinline__ void attn_prompt_unit(const Params& P, LAS unsigned char* lds, int b, int h, int qblk) {
    const int tid = threadIdx.x, lane = tid & 63, wid = __builtin_amdgcn_readfirstlane(tid >> 6), r32 = lane & 31, hi = lane >> 5;
    const bf16* qb = (const bf16*)(P.ws + WS_Q); const bf16* kb = (const bf16*)(P.ws + WS_K); const bf16* vb = (const bf16*)(P.ws + WS_V);
    bf16* mix = (bf16*)(P.ws + WS_MIX);
    const float* cum = (const float*)(P.ws + WS_CUMP) + (size_t)(b * NH + h) * SEQ;
    const int q0 = qblk * 256, rowbase = b * SEQ, NT = (q0 + 256) / 64;
    LAS float* ckl = (LAS float*)(lds + LDS_AUX);
    const int qrel = q0 + 32 * wid + r32;
    const int kvK = (tid & 7) + 8 * (tid >> 6), cK = (tid >> 3) & 7, cV = (tid & 3) + 4 * ((tid >> 5) & 1), kvV = ((tid >> 2) & 7) + 8 * (tid >> 6);
    const bf16* ksrc = kb + (size_t)(rowbase + kvK) * DA + h * 64 + cK * 8;
    const bf16* vsrc = vb + (size_t)(rowbase + kvV) * DA + h * 64 + cV * 8;
    const int kdst = cK * 1024 + kvK * 16, vdst = 8192 + (cV >> 2) * 4096 + kvV * 64 + (cV & 3) * 16;
    float cv[4];
#pragma unroll
    for (int i = 0; i < 4; ++i) { const int t = tid + 512 * i; cv[i] = (t < q0 + 256) ? cum[t] : 0.f; }
    u32x4 kra = *(const u32x4*)ksrc, vra = *(const u32x4*)vsrc, krb = *(const u32x4*)(ksrc + (size_t)64 * DA), vrb = *(const u32x4*)(vsrc + (size_t)64 * DA);
    bf16x8 qf[4];
#pragma unroll
    for (int d0 = 0; d0 < 4; ++d0) qf[d0] = *(const bf16x8*)(qb + (size_t)(rowbase + qrel) * DA + h * 64 + d0 * 16 + hi * 8);
    float cqm = cum[qrel];
    __builtin_amdgcn_sched_barrier(0);
#pragma unroll
    for (int i = 0; i < 4; ++i) { const int t = tid + 512 * i; if (t < q0 + 256) ckl[t] = cv[i]; }
    *(LAS u32x4*)(lds + kdst) = kra; *(LAS u32x4*)(lds + vdst) = vra; *(LAS u32x4*)(lds + 16384 + kdst) = krb; *(LAS u32x4*)(lds + 16384 + vdst) = vrb;
    __syncthreads();
    f32x16 o0, o1;
#pragma unroll
    for (int r = 0; r < 16; ++r) { o0[r] = 0.f; o1[r] = 0.f; }
    float m_run = 0.f, l_run = 0.f;
    const int qmin = q0 + 32 * wid, qmax = qmin + 31;
    for (int t = 0; t < NT; t += 2) {
        const int tn = (t + 2 < NT) ? t + 2 : t;
        kra = *(const u32x4*)(ksrc + (size_t)tn * 64 * DA); vra = *(const u32x4*)(vsrc + (size_t)tn * 64 * DA);
        krb = *(const u32x4*)(ksrc + (size_t)(tn + 1) * 64 * DA); vrb = *(const u32x4*)(vsrc + (size_t)(tn + 1) * 64 * DA);
        const LAS unsigned char* buf = lds + ((t >> 1) & 1) * 32768;
        if (64 * t <= qmax) attn_tile(buf, buf + 8192, ckl + 64 * t, cqm, 64 * t, qrel, 64 * t + 63 > qmin, qf, o0, o1, m_run, l_run, lane);
        if (64 * (t + 1) <= qmax) attn_tile(buf + 16384, buf + 16384 + 8192, ckl + 64 * (t + 1), cqm, 64 * (t + 1), qrel, 64 * (t + 1) + 63 > qmin, qf, o0, o1, m_run, l_run, lane);
        asm volatile("" ::: "memory"); __builtin_amdgcn_sched_barrier(0);
        { LAS unsigned char* nb = lds + (((t >> 1) + 1) & 1) * 32768;
            *(LAS u32x4*)(nb + kdst) = kra; *(LAS u32x4*)(nb + vdst) = vra; *(LAS u32x4*)(nb + 16384 + kdst) = krb; *(LAS u32x4*)(nb + 16384 + vdst) = vrb; }
        __syncthreads();
    }
    const float inv = 1.0f / l_run;
    bf16* op = mix + (size_t)(rowbase + qrel) * DM + DC + h * 64 + 4 * hi;
#pragma unroll
    for (int g = 0; g < 4; ++g) {
        u32x2 w0, w1;
        w0.x = pk2(o0[4 * g] * inv, o0[4 * g + 1] * inv); w0.y = pk2(o0[4 * g + 2] * inv, o0[4 * g + 3] * inv);
        w1.x = pk2(o1[4 * g] * inv, o1[4 * g + 1] * inv); w1.y = pk2(o1[4 * g + 2] * inv, o1[4 * g + 3] * inv);
        *(u32x2*)(op + 8 * g) = w0; *(u32x2*)(op + 32 + 8 * g) = w1;
    }
}

__device__ __forceinline__ void attn_sample_unit(const Params& P, LAS unsigned char* lds, int b, int h) {
    const int tid = threadIdx.x, lane = tid & 63, wid = __builtin_amdgcn_readfirstlane(tid >> 6), r32 = lane & 31, hi = lane >> 5;
    const bf16* qb = (const bf16*)(P.ws + WS_Q); const bf16* kb = (const bf16*)(P.ws + WS_K); const bf16* vb = (const bf16*)(P.ws + WS_V);
    bf16* mix = (bf16*)(P.ws + WS_MIX);
    const float* cum = (const float*)(P.ws + WS_CUMS) + (size_t)(b * NH + h) * SKV;
    LAS float* ckl = (LAS float*)(lds + LDS_AUX);
    const int rowbase = MP + b * DS;
    float cv[3];
#pragma unroll
    for (int i = 0; i < 3; ++i) { const int t = tid + 512 * i; cv[i] = (t < SKV) ? cum[t] : 0.f; }
    bf16x8 qf[4];
#pragma unroll
    for (int d0 = 0; d0 < 4; ++d0) { qf[d0] = (bf16x8){0, 0, 0, 0, 0, 0, 0, 0}; if (r32 < DS) qf[d0] = *(const bf16x8*)(qb + (size_t)(rowbase + r32) * DA + h * 64 + d0 * 16 + hi * 8); }
    float cqm = (r32 < DS) ? cum[PAST + r32] : 0.f;
    __builtin_amdgcn_sched_barrier(0);
#pragma unroll
    for (int i = 0; i < 3; ++i) { const int t = tid + 512 * i; if (t < 17 * 64) ckl[t] = cv[i]; }
    __syncthreads();
    const int qpos = PAST + r32;
    LAS unsigned char* Kw = lds + wid * 16384; LAS unsigned char* Vw = Kw + 8192;
    f32x16 o0, o1;
#pragma unroll
    for (int r = 0; r < 16; ++r) { o0[r] = 0.f; o1[r] = 0.f; }
    float m_run = 0.f, l_run = 0.f;
    const int ntl = (wid == 0) ? 3 : 2;
    for (int i = 0; i < ntl; ++i) {
        const int t = wid + 8 * i;
        if (t < 16) {
            const float* kc = P.in[2] + ((size_t)(b * PAST + 64 * t) * NH + h) * HD;
            const float* vc = P.in[3] + ((size_t)(b * PAST + 64 * t) * NH + h) * HD;
            {
                const int kvl = (lane >> 1) & 7, cl = lane >> 4, half = lane & 1, f4 = lane & 7, kvv = (lane >> 3) & 7;
                f32x4 xk[16], xv[16];
#pragma unroll
                for (int rg = 0; rg < 8; ++rg)
#pragma unroll
                    for (int ch = 0; ch < 2; ++ch) xk[rg * 2 + ch] = *(const f32x4*)(kc + (size_t)(8 * rg + kvl) * (NH * HD) + (4 * ch + cl) * 8 + half * 4);
#pragma unroll
                for (int rg = 0; rg < 8; ++rg)
#pragma unroll
                    for (int dh = 0; dh < 2; ++dh) xv[rg * 2 + dh] = *(const f32x4*)(vc + (size_t)(8 * rg + kvv) * (NH * HD) + 32 * dh + 4 * f4);
#pragma unroll
                for (int rg = 0; rg < 8; ++rg)
#pragma unroll
                    for (int ch = 0; ch < 2; ++ch) { const f32x4 y = xk[rg * 2 + ch]; u32x2 w; w.x = pk2(y[0], y[1]); w.y = pk2(y[2], y[3]);
                        *(LAS u32x2*)(Kw + (4 * ch + cl) * 1024 + (8 * rg + kvl) * 16 + half * 8) = w; }
#pragma unroll
                for (int rg = 0; rg < 8; ++rg)
#pragma unroll
                    for (int dh = 0; dh < 2; ++dh) { const f32x4 y = xv[rg * 2 + dh]; u32x2 w; w.x = pk2(y[0], y[1]); w.y = pk2(y[2], y[3]);
                        *(LAS u32x2*)(Vw + dh * 4096 + (8 * rg + kvv) * 64 + f4 * 8) = w; } }
        } else {
#pragma unroll
            for (int e = 0; e < 16; ++e) *(LAS u32x4*)(Kw + (e * 64 + lane) * 16) = (u32x4){0u, 0u, 0u, 0u};
            LDS_WAIT();
#pragma unroll
            for (int e = 0; e < 2; ++e) { const int item = lane + 64 * e, row = item & 15, c = item >> 4;
                const u32x4 kk = *(const u32x4*)(kb + (size_t)(rowbase + row) * DA + h * 64 + c * 8), vv = *(const u32x4*)(vb + (size_t)(rowbase + row) * DA + h * 64 + c * 8);
                *(LAS u32x4*)(Kw + c * 1024 + row * 16) = kk; *(LAS u32x4*)(Vw + (c >> 2) * 4096 + row * 64 + (c & 3) * 16) = vv; }
        }
        LDS_WAIT();
        attn_tile(Kw, Vw, ckl + 64 * t, cqm, 64 * t, qpos, t == 16, qf, o0, o1, m_run, l_run, lane);
        LDS_WAIT();
    }
    __syncthreads();
    LAS float* OS = (LAS float*)lds;
    LAS float* MS_ = (LAS float*)(lds + 32768);
    if (r32 < DS) {
#pragma unroll
        for (int g = 0; g < 4; ++g) {
            *(LAS f32x4*)(OS + (wid * 16 + r32) * 64 + 8 * g + 4 * hi) = (f32x4){o0[4 * g], o0[4 * g + 1], o0[4 * g + 2], o0[4 * g + 3]};
            *(LAS f32x4*)(OS + (wid * 16 + r32) * 64 + 32 + 8 * g + 4 * hi) = (f32x4){o1[4 * g], o1[4 * g + 1], o1[4 * g + 2], o1[4 * g + 3]};
        }
        if (hi == 0) { MS_[wid * 16 + r32] = m_run; MS_[128 + wid * 16 + r32] = l_run; }
    }
    __syncthreads();
    { const int q = tid >> 5, d = 2 * (tid & 31);
        float m = MS_[q];
#pragma unroll
        for (int w = 1; w < 8; ++w) m = fmaxf(m, MS_[w * 16 + q]);
        float L = 0.f, a0 = 0.f, a1 = 0.f;
#pragma unroll
        for (int w = 0; w < 8; ++w) { const float sc = __builtin_amdgcn_exp2f(MS_[w * 16 + q] - m); L += MS_[128 + w * 16 + q] * sc;
            a0 += OS[(w * 16 + q) * 64 + d] * sc; a1 += OS[(w * 16 + q) * 64 + d + 1] * sc; }
        const float inv = 1.0f / L;
        *(unsigned*)(mix + (size_t)(rowbase + q) * DM + DC + h * 64 + d) = pk2(a0 * inv, a1 * inv);
    }
    __syncthreads();
}

template <int TPW, int NPASS>
__device__ __forceinline__ void conv_item(const Params& P, LAS unsigned char* lds, bool sample, int b, int t0) {
    constexpr int NTOK = 8 * TPW * NPASS, NR = NTOK + 32, NST = NR * 64 / 512;
    const int tid = threadIdx.x, lane = tid & 63, wid = __builtin_amdgcn_readfirstlane(tid >> 6);
    const bf16* u = (const bf16*)(P.ws + WS_U);
    bf16* mix = (bf16*)(P.ws + WS_MIX);
    const int rowbase = sample ? MP + b * DS : b * SEQ;
    u32x4 sv[NST];
#pragma unroll
    for (int i = 0; i < NST; ++i) { const int e = tid + 512 * i, r = e >> 6, c8 = e & 63, t = t0 - 30 + r;
        sv[i] = (u32x4){0u, 0u, 0u, 0u};
        if (r < NTOK + 30) {
            if (t >= 0) sv[i] = *(const u32x4*)(u + (size_t)(rowbase + t) * DC + 8 * c8);
            else if (sample) { const float* sp = P.in[5] + ((size_t)b * 30 + (30 + t)) * DC + 8 * c8; const f32x4 x0 = *(const f32x4*)sp, x1 = *(const f32x4*)(sp + 4);
                sv[i] = (u32x4){pk2(x0[0], x0[1]), pk2(x0[2], x0[3]), pk2(x1[0], x1[1]), pk2(x1[2], x1[3])}; } } }
    typedef float f32x2v __attribute__((ext_vector_type(2)));
    float cb[8], lg[8], lb[8];
#pragma unroll
    for (int i = 0; i < 4; ++i) { const f32x2v a = *(const f32x2v*)(P.in[16] + 2 * lane + 128 * i), g = *(const f32x2v*)(P.in[17] + 2 * lane + 128 * i), c = *(const f32x2v*)(P.in[18] + 2 * lane + 128 * i);
        cb[2 * i] = a[0]; cb[2 * i + 1] = a[1]; lg[2 * i] = g[0]; lg[2 * i + 1] = g[1]; lb[2 * i] = c[0]; lb[2 * i + 1] = c[1]; }
#pragma unroll
    for (int i = 0; i < NST; ++i) { const int e = tid + 512 * i; *(LAS u32x4*)(lds + (e >> 6) * 1024 + (e & 63) * 16) = sv[i]; }
    constexpr int WOFF = NR * 1024;
    { f32x4 wr[8];
#pragma unroll
        for (int i = 0; i < 8; ++i) { const int e = tid + 512 * i, r = e >> 7, c4 = e & 127; wr[i] = (f32x4){0.f, 0.f, 0.f, 0.f}; if (r < CW) wr[i] = *(const f32x4*)(P.in[15] + (size_t)r * DC + 4 * c4); }
#pragma unroll
        for (int i = 0; i < 8; ++i) { const int e = tid + 512 * i, r = e >> 7, c4 = e & 127; u32x2 w; w.x = pk2(wr[i][0], wr[i][1]); w.y = pk2(wr[i][2], wr[i][3]); *(LAS u32x2*)(lds + WOFF + r * 1024 + c4 * 8) = w; } }
    __syncthreads();
    const LAS unsigned char* wl = lds + WOFF + lane * 4;
#pragma unroll 1
    for (int pass = 0; pass < NPASS; ++pass) {
    const int tok0 = (wid * NPASS + pass) * TPW;
    float acc[TPW][8];
#pragma unroll
    for (int k = 0; k < TPW; ++k)
#pragma unroll
        for (int i = 0; i < 8; ++i) acc[k][i] = 0.f;
    float wv[4][8];
#pragma unroll
    for (int s = 0; s < 4; ++s)
#pragma unroll
        for (int i = 0; i < 8; ++i) wv[s][i] = 0.f;
    const LAS unsigned char* ub = lds + tok0 * 1024 + lane * 4;
    constexpr int NM = ((TPW + 30 + 3) / 4) * 4;
#pragma unroll 1
    for (int mb = 0; mb < NM; mb += 4) {
#pragma unroll
        for (int s = 0; s < 4; ++s) {
            const int m = mb + s, mw = (m <= 30) ? m : 31;
#pragma unroll
            for (int i = 0; i < 4; ++i) { const unsigned x = *(const LAS unsigned*)(wl + mw * 1024 + 256 * i); wv[s][2 * i] = __uint_as_float(x << 16); wv[s][2 * i + 1] = __uint_as_float(x & 0xffff0000u); }
            float uv[8];
#pragma unroll
            for (int i = 0; i < 4; ++i) { const unsigned x = *(const LAS unsigned*)(ub + m * 1024 + 256 * i); uv[2 * i] = __uint_as_float(x << 16); uv[2 * i + 1] = __uint_as_float(x & 0xffff0000u); }
#pragma unroll
            for (int k = 0; k < TPW; ++k)
#pragma unroll
                for (int i = 0; i < 8; ++i) acc[k][i] += uv[i] * wv[(s - k) & 3][i];
        }
    }
#pragma unroll
    for (int kg = 0; kg < TPW; kg += 4) {
        float st[8];
#pragma unroll
        for (int q = 0; q < 8; ++q) st[q] = 0.f;
#pragma unroll
        for (int k = 0; k < 4; ++k) if (kg + k < TPW) {
            float s1 = 0.f, s2 = 0.f;
#pragma unroll
            for (int i = 0; i < 8; ++i) { acc[kg + k][i] += cb[i]; s1 += acc[kg + k][i]; s2 += acc[kg + k][i] * acc[kg + k][i]; }
            st[k] = s1; st[4 + k] = s2; }
        float zt;
        { const bool b5 = (lane & 32) != 0, b4 = (lane & 16) != 0, b3 = (lane & 8) != 0; float g4[4], h2[2];
#pragma unroll
            for (int q = 0; q < 4; ++q) { const float snd = b5 ? st[q] : st[q + 4], kp = b5 ? st[q + 4] : st[q]; g4[q] = kp + __shfl_xor(snd, 32); }
#pragma unroll
            for (int q = 0; q < 2; ++q) { const float snd = b4 ? g4[q] : g4[q + 2], kp = b4 ? g4[q + 2] : g4[q]; h2[q] = kp + __shfl_xor(snd, 16); }
            { const float snd = b3 ? h2[0] : h2[1], kp = b3 ? h2[1] : h2[0]; zt = kp + __shfl_xor(snd, 8); }
            zt += __shfl_xor(zt, 4); zt += __shfl_xor(zt, 2); zt += __shfl_xor(zt, 1); }
#pragma unroll
        for (int k = 0; k < 4; ++k) if (kg + k < TPW) {
            const float sum1 = __uint_as_float(__builtin_amdgcn_readlane(__float_as_uint(zt), 8 * k)), sum2 = __uint_as_float(__builtin_amdgcn_readlane(__float_as_uint(zt), 8 * (4 + k)));
            const float mu = sum1 * (1.0f / DC), var = fmaxf(sum2 * (1.0f / DC) - mu * mu, 0.f);
            const float rstd = rsqrtf(var + EPS);
            bf16* op = mix + (size_t)(rowbase + t0 + tok0 + kg + k) * DM + 2 * lane;
#pragma unroll
            for (int i = 0; i < 4; ++i) { const float y0 = (acc[kg + k][2 * i] - mu) * rstd * lg[2 * i] + lb[2 * i], y1 = (acc[kg + k][2 * i + 1] - mu) * rstd * lg[2 * i + 1] + lb[2 * i + 1];
                *(unsigned*)(op + 128 * i) = pk2(y0 * sigmoidf_(y0), y1 * sigmoidf_(y1)); }
        }
    }
    }
    __syncthreads();
}

__device__ __forceinline__ void p3_phase(const Params& P, LAS unsigned char* lds) {
    const int G = gridDim.x, bx = blockIdx.x;
#ifndef P3PARTS
#define P3PARTS 31
#endif
#ifndef P3REP
#define P3REP 0
#endif
    const bool sample_first = ((bx >> 3) & 1) != 0;
    if (sample_first) {
    for (int r2 = 0; r2 < 1 + ((P3REP >> 1) & 1); ++r2)
    if (P3PARTS & 2) for (int it = bx; it < DB * NH; it += G) attn_sample_unit(P, lds, it >> 3, it & 7);
    }
    for (int r1 = 0; r1 < 1 + (P3REP & 1); ++r1)
    if (P3PARTS & 1) for (int it = bx; it < 256; it += G) { const int bh = it >> 2, p = it & 3; attn_prompt_unit(P, lds, bh >> 3, bh & 7, 7 - p); attn_prompt_unit(P, lds, bh >> 3, bh & 7, p); }
    for (int r3 = 0; r3 < 1 + ((P3REP >> 2) & 1); ++r3)
    if (P3PARTS & 4) for (int it = bx; it < 256; it += G) conv_item<4, 2>(P, lds, false, it >> 5, (it & 31) * 64);
    if (P3PARTS & 8) for (int it = (bx + G - 32 % G) % G; it < DB; it += G) conv_item<2, 1>(P, lds, true, it, 0);
    if (!sample_first) {
    for (int r2 = 0; r2 < 1 + ((P3REP >> 1) & 1); ++r2)
    if (P3PARTS & 2) for (int it = bx; it < DB * NH; it += G) attn_sample_unit(P, lds, it >> 3, it & 7);
    }
    const int gt = bx * 512 + threadIdx.x, GT = G * 512;
    for (int e = gt; e < DB * (30 - DS) * 128; e += GT) { const int c4 = e & 127, r = (e >> 7) % (30 - DS), b = (e >> 7) / (30 - DS);
        *(f32x4*)(P.out + OFF_CS + ((size_t)b * 30 + r) * DC + 4 * c4) = *(const f32x4*)(P.in[5] + ((size_t)b * 30 + DS + r) * DC + 4 * c4); }
}

constexpr size_t WS_CTL = 3 * MiB + MiB / 2, CTL_BYTES = 16384; static_assert(WS_CUMS + (size_t)DB * NH * SKV * 4 <= WS_CTL && WS_CUMP + (size_t)NB * NH * SEQ * 4 <= WS_CUMS && WS_CTL + CTL_BYTES <= WS_WIN, "ctl map");
constexpr int LDS_MISC = 143360;
#define XB_TMO      128
#define XB_XCNT(j)  (256  + 64 * (j))
#define XB_XSUB(j)  (1280 + 64 * (j))
#define XB_XGEN(j)  (2304 + 64 * (j))
#define XB_TOP      3328
#define XB_TOPGEN   3392
#define XCD_BAR_WORDS 3456
#define XB_SPIN_CAP (1u << 18)

__device__ __forceinline__ unsigned xb_ld(unsigned* p)              { return __hip_atomic_load(p, __ATOMIC_RELAXED, __HIP_MEMORY_SCOPE_AGENT); }
__device__ __forceinline__ unsigned xb_add(unsigned* p, unsigned v) { return __hip_atomic_fetch_add(p, v, __ATOMIC_RELAXED, __HIP_MEMORY_SCOPE_AGENT); }
__device__ __forceinline__ unsigned xb_xcc_id() { return (unsigned)__builtin_amdgcn_s_getreg((3 << 11) | 20) & 0xFu; }
#define XB_SPIN(cond, bar) do { unsigned _sp = 0; while (cond) { __builtin_amdgcn_s_sleep(1); \
    if ((++_sp & 255u) == 0u) { if (xb_ld(&(bar)[XB_TMO])) break; if (_sp > XB_SPIN_CAP) { atomicAdd(&(bar)[XB_TMO], 1u); break; } } } } while (0)

struct XcdBarrier {
    unsigned* bar; unsigned x;
    volatile LAS unsigned* st;
};

__device__ __forceinline__ XcdBarrier xcd_barrier_post(unsigned* bar, volatile LAS unsigned* st) {
    XcdBarrier b; b.bar = bar; b.x = xb_xcc_id(); b.st = st;
    if (threadIdx.x == 0) (void)xb_add(&bar[XB_XCNT(b.x)], 1u);
    return b;
}
__device__ __forceinline__ void xcd_barrier_complete(unsigned* bar, unsigned x, unsigned& nloc, unsigned& nx) {
    const unsigned G = gridDim.x * gridDim.y * gridDim.z;
    unsigned sum, cnt, mine, sp = 0u;
    for (;;) {
        sum = 0u; cnt = 0u; mine = 0u;
#pragma unroll
        for (unsigned j = 0; j < 16; ++j) { const unsigned c = xb_ld(&bar[XB_XCNT(j)]); sum += c; cnt += (c > 0u) ? 1u : 0u; mine = (j == x) ? c : mine; }
        if (sum == G) break;
        __builtin_amdgcn_s_sleep(1);
        if ((++sp & 255u) == 0u) { if (xb_ld(&bar[XB_TMO])) break; if (sp > XB_SPIN_CAP) { atomicAdd(&bar[XB_TMO], 1u); break; } }
    }
    nloc = mine > 0u ? mine : 1u; nx = cnt > 0u ? cnt : 1u;
}

__device__ __forceinline__ void xcd_barrier(const XcdBarrier& b) {
    asm volatile("s_waitcnt vmcnt(0)" ::: "memory");
    __syncthreads();
    if (threadIdx.x == 0) {
        unsigned* bar = b.bar;
        __builtin_amdgcn_s_waitcnt(0);
        unsigned nloc = b.st[0], nx = b.st[1];
        if (nloc == 0u) { xcd_barrier_complete(bar, b.x, nloc, nx); b.st[0] = nloc; b.st[1] = nx; }
        const unsigned old = xb_add(&bar[XB_XSUB(b.x)], 1u);
        const unsigned gen = old / nloc;
        if (old + 1u == (gen + 1u) * nloc) {
            __builtin_amdgcn_fence(__ATOMIC_RELEASE, "agent");
            asm volatile("s_waitcnt vmcnt(0)" ::: "memory");
            const unsigned og = xb_add(&bar[XB_TOP], 1u);
            const unsigned tg = og / nx;
            if (og + 1u == (tg + 1u) * nx) xb_add(&bar[XB_TOPGEN], 1u);
            else XB_SPIN(xb_ld(&bar[XB_TOPGEN]) == tg, bar);
            __builtin_amdgcn_fence(__ATOMIC_ACQUIRE, "agent");
            xb_add(&bar[XB_XGEN(b.x)], 1u);
            asm volatile("s_waitcnt vmcnt(0)" ::: "memory");
        } else {
            XB_SPIN(xb_ld(&bar[XB_XGEN(b.x)]) == gen, bar);
            __builtin_amdgcn_fence(__ATOMIC_ACQUIRE, "agent");
            asm volatile("s_waitcnt vmcnt(0)" ::: "memory");
        }
    }
    __syncthreads();
}


__global__ void __launch_bounds__(512, 2) fwd_megakernel(Params P) {
    extern __shared__ __attribute__((aligned(16))) unsigned char lds_raw[];
    LAS unsigned char* lds = (LAS unsigned char*)lds_raw;
    cg::grid_group grid = cg::this_grid();
    if (threadIdx.x < 16) ((LAS unsigned*)(lds + LDS_MISC))[threadIdx.x] = 0u;
    __syncthreads();
    const XcdBarrier xbar = xcd_barrier_post((unsigned*)(P.ws + WS_CTL), (volatile LAS unsigned*)(lds + LDS_MISC));
    if (P.ph_lo < 0) grid.sync();
    const int lo = P.ph_lo, hi = P.ph_hi;
#ifndef PHMASK
#define PHMASK 0x1FF
#endif
#define IN(k) ((((PHMASK) >> (k)) & 1) && lo <= (k) && (k) < hi)
#ifndef REPMASK
#define REPMASK 0
#endif
#ifndef SYNCREP
#define SYNCREP 1
#endif
#define NREP(k) (1 + (((REPMASK) >> (k)) & 1))
#define SEAM(k) do { if (IN(k) && IN((k) + 1)) for (int sr_ = 0; sr_ < SYNCREP; ++sr_) xcd_barrier(xbar); } while (0)
    float* mod = (float*)(P.ws + WS_MOD);
    if (IN(0)) for (int rep = 0; rep < NREP(0); ++rep) { p0_phase(P, lds);
        {
            const int G = (int)gridDim.x, wv = __builtin_amdgcn_readfirstlane(threadIdx.x >> 6);
            if (G <= 192) convert_items(P, lds, 0, I_IN, (int)blockIdx.x * 8 + wv, G * 8);
            else if ((int)blockIdx.x >= 192) convert_items(P, lds, 0, I_IN, ((int)blockIdx.x - 192) * 8 + wv, (G - 192) * 8);
        } }
    SEAM(0);
    if (IN(1)) for (int rep = 0; rep < NREP(1); ++rep) { norm_phase<true, false>(P, lds, P.in[0], P.in[1], P.in[10], MOD_SH1, MOD_SC1, nullptr, nullptr, nullptr); }
    SEAM(1);
    if (IN(2)) for (int rep = 0; rep < NREP(2); ++rep) {
#ifndef NO_CUMSUM
        cumsum_items(P);
#endif
        pg8::Gemm g{(const pg8::bf16_t*)(P.ws + WS_H), (const pg8::bf16_t*)(P.ws + WS_WIN), MT, NIN, DM, DM}; pg8::StaticOrder S; S.init(MT, NIN, (int)gridDim.x, (int)blockIdx.x);
        EpiIn E{(float*)(P.ws + WS_U), (bf16*)(P.ws + WS_Q), P.out, P.in[13], (long)(P.in[14] - P.in[13])};
        pg8::gemm_phase<EpiIn, pg8::StaticOrder, true, true>(lds, g, S, E);
        {
            const int G = (int)gridDim.x, nun = (MT / 256) * (NIN / 256), rem = nun % G;
            const int wv = __builtin_amdgcn_readfirstlane(threadIdx.x >> 6);
            if (rem == 0) convert_items(P, lds, I_IN, I_IN + I_OUT, (int)blockIdx.x * 8 + wv, G * 8);
            else if ((int)blockIdx.x >= rem) convert_items(P, lds, I_IN, I_IN + I_OUT, ((int)blockIdx.x - rem) * 8 + wv, (G - rem) * 8);
        }
    }
    SEAM(2);
    if (IN(3)) for (int rep = 0; rep < NREP(3); ++rep) { p3_phase(P, lds); }
    SEAM(3);
    if (IN(4)) for (int rep = 0; rep < NREP(4); ++rep) {
        pg8::Gemm g{(const pg8::bf16_t*)(P.ws + WS_MIX), (const pg8::bf16_t*)(P.ws + WS_WOUT), MT, DM, DM, DM};
        ResOrder S; S.so.init(MP, DM, (int)gridDim.x, (int)blockIdx.x); S.nsub = 8 * 4; S.ksub = 256;
        EpiRes2<true, false> E{EpiRes<true, false>{P.in[0], P.in[1], (float*)(P.ws + WS_X1), (float*)(P.ws + WS_X1) + (size_t)MP * DM, mod + MOD_G1}, EpiSlab{(float*)(P.ws + WS_SLAB4)}};
        pg8::gemm_phase<EpiRes2<true, false>, ResOrder, true, true>(lds, g, S, E);
        {
            const int G = (int)gridDim.x, rem = (256 + 8 * 4) % G, wv = __builtin_amdgcn_readfirstlane(threadIdx.x >> 6);
            if (rem == 0) convert_items(P, lds, I_IN + I_OUT, I_IN + I_OUT + 2 * I_G, (int)blockIdx.x * 8 + wv, G * 8);
            else if ((int)blockIdx.x >= rem) convert_items(P, lds, I_IN + I_OUT, I_IN + I_OUT + 2 * I_G, ((int)blockIdx.x - rem) * 8 + wv, (G - rem) * 8);
        }
    }
    SEAM(4);
    if (IN(5)) for (int rep = 0; rep < NREP(5); ++rep) { norm_phase<false, true>(P, lds, (const float*)(P.ws + WS_X1), P.in[1], P.in[20], MOD_SH2, MOD_SC2, (const float*)(P.ws + WS_SLAB4), mod + MOD_G1, (float*)(P.ws + WS_X1) + (size_t)MP * DM);     }
    SEAM(5);
    if (IN(6)) for (int rep = 0; rep < NREP(6); ++rep) {
        pg8::Gemm g{(const pg8::bf16_t*)(P.ws + WS_H), (const pg8::bf16_t*)(P.ws + WS_WGU), MT, NGU, DM, DM}; pg8::StaticOrder S; S.init(MT, NGU, (int)gridDim.x, (int)blockIdx.x);
        EpiGU E{(bf16*)(P.ws + WS_ACT)};
        pg8::gemm_phase<EpiGU, pg8::StaticOrder, true, true>(lds, g, S, E);
        {
            const int G = (int)gridDim.x, rem = ((MT / 256) * (NGU / 256)) % G, wv = __builtin_amdgcn_readfirstlane(threadIdx.x >> 6);
            if (rem == 0) convert_items(P, lds, I_IN + I_OUT + 2 * I_G, NITEMS, (int)blockIdx.x * 8 + wv, G * 8);
            else if ((int)blockIdx.x >= rem) convert_items(P, lds, I_IN + I_OUT + 2 * I_G, NITEMS, ((int)blockIdx.x - rem) * 8 + wv, (G - rem) * 8);
        }
    }
    SEAM(6);
    if (IN(7)) for (int rep = 0; rep < NREP(7); ++rep) {
        pg8::Gemm g{(const pg8::bf16_t*)(P.ws + WS_ACT), (const pg8::bf16_t*)(P.ws + WS_WDN), MT, DM, DFF, DFF};
        ResOrder S; S.so.init(MP, DM, (int)gridDim.x, (int)blockIdx.x); S.nsub = 8 * 11; S.ksub = 256;
        EpiRes2<false, true> E{EpiRes<false, true>{(const float*)(P.ws + WS_X1), (const float*)(P.ws + WS_X1) + (size_t)MP * DM, P.out + OFF_YP, P.out + OFF_YS, mod + MOD_G2}, EpiSlab{(float*)(P.ws + WS_SLAB7)}};
        pg8::gemm_phase<EpiRes2<false, true>, ResOrder, true, true>(lds, g, S, E);
    }
    SEAM(7);
    if (IN(8)) {
        const float* x1s = (const float*)(P.ws + WS_X1) + (size_t)MP * DM; const float* slab = (const float*)(P.ws + WS_SLAB7);
        for (int e = blockIdx.x * 512 + threadIdx.x; e < MS * (DM / 4); e += gridDim.x * 512) { const int r = e >> 8, c = 4 * (e & 255);
            f32x4 sm = *(const f32x4*)(slab + (size_t)r * DM + c);
#pragma unroll
            for (int ks = 1; ks < 11; ++ks) sm += *(const f32x4*)(slab + ((size_t)ks * MS + r) * DM + c);
            *(f32x4*)(P.out + OFF_YS + (size_t)r * DM + c) = *(const f32x4*)(x1s + (size_t)r * DM + c) + *(const f32x4*)(mod + (size_t)mod_row_of(MP + r) * 6144 + MOD_G2 + c) * sm; }
    }
#undef IN
#undef SEAM
}

#ifndef N_LAUNCH_SPLIT
#define N_LAUNCH_SPLIT 0
#endif
extern "C" void kernel_launch(void* const* d_in, const int* in_sizes, int n_in, void* d_out, int out_size, void* d_ws, size_t ws_size, hipStream_t stream) {
    static int grid = 0;
    if (grid == 0) {
        if (n_in != 24 || (size_t)out_size != OUT_TOTAL || ws_size < WS_END) { fprintf(stderr, "kernel_launch: unexpected shapes (n_in %d, out %d, ws %zu)\n", n_in, out_size, ws_size); grid = -1; return; }
        int dev = 0, cus = 0, per_cu = 0;
        (void)hipGetDevice(&dev); (void)hipDeviceGetAttribute(&cus, hipDeviceAttributeMultiprocessorCount, dev);
        if (hipFuncSetAttribute((const void*)fwd_megakernel, hipFuncAttributeMaxDynamicSharedMemorySize, LDS_BYTES) != hipSuccess) { fprintf(stderr, "kernel_launch: hipFuncSetAttribute failed\n"); grid = -1; return; }
        if (hipOccupancyMaxActiveBlocksPerMultiprocessor(&per_cu, (const void*)fwd_megakernel, 512, LDS_BYTES) != hipSuccess || per_cu < 1) { fprintf(stderr, "kernel_launch: occupancy query says %d\n", per_cu); per_cu = 1; }
        (void)hipGetLastError();
        grid = cus * 1;
        if (grid <= 0) grid = 256;
    }
    if (grid < 0) return;
    if (hipMemsetAsync((char*)d_ws + WS_CTL, 0, CTL_BYTES, stream) != hipSuccess) { fprintf(stderr, "kernel_launch: memset failed\n"); return; }
    Params p{};
    for (int i = 0; i < 24; ++i) p.in[i] = (const float*)d_in[i];
    p.out = (float*)d_out; p.ws = (unsigned char*)d_ws;
#if N_LAUNCH_SPLIT
    for (int ph = 0; ph < 9; ++ph) { p.ph_lo = ph; p.ph_hi = ph + 1; hipLaunchKernelGGL(fwd_megakernel, dim3(grid), dim3(512), LDS_BYTES, stream, p); }
#else
    p.ph_lo = 0; p.ph_hi = 9;
    void* args[] = {&p};
    hipError_t e = hipLaunchCooperativeKernel((const void*)fwd_megakernel, dim3(grid), dim3(512), args, LDS_BYTES, stream);
    if (e != hipSuccess) fprintf(stderr, "kernel_launch: cooperative launch failed: %s (grid %d)\n", hipGetErrorString(e), grid);
#endif
}
```

```cpp
#include <hip/hip_runtime.h>
#include <hip/hip_cooperative_groups.h>
#include <cstdio>
#include <cstdint>
namespace cg = cooperative_groups;
namespace pg8 {
#define PG8_LAS __attribute__((address_space(3)))
typedef unsigned short bf16_t;
typedef short bf16x8 __attribute__((ext_vector_type(8)));
typedef float f32x4 __attribute__((ext_vector_type(4)));
typedef unsigned u32x4 __attribute__((ext_vector_type(4)));
constexpr int BM = 256, BK = 64, HALF = 128, HTB = HALF * BK * 2  , STAGE_BYTES = 8 * HTB, NXCD = 8, WGM = 8;

__host__ __device__ __forceinline__ int lds_byte(int r, int c) { const int st = (r >> 4) * 2 + (c >> 5), rr = r & 15, cc = c & 31, ob = rr * 64 + cc * 2; return st * 1024 + (ob ^ (((ob >> 9) & 1) << 5)); }
__host__ __device__ __forceinline__ void stage_rc(int b, int& R, int& C) { const int st = b / 1024, sb = b % 1024, swz = sb ^ (((sb >> 9) & 1) << 5); R = (st >> 1) * 16 + swz / 64; C = (st & 1) * 32 + (swz % 64) / 2; }
__host__ __device__ __forceinline__ int perm32(int rho) { const int n = rho >> 4, i = rho & 15; return 8 * (i >> 2) + 4 * n + (i & 3); }

struct Unit { int pm, pn, koff, nt; };
struct Gemm { const bf16_t* A; const bf16_t* Bt; int M, N, K, ld; };

struct StaticOrder {
    int nM, nN, nwg, G, c;
    __host__ __device__ void init(int M, int N, int G_, int c_) { nM = M / BM; nN = N / BM; nwg = nM * nN; G = G_; c = c_; }
    __host__ __device__ bool next(int i, Unit& u) const {
        const long L = (long)i * G + c; if (L >= nwg) return false;
        int wgid = (int)L; { const int q = nwg / NXCD, r = nwg % NXCD, xcd = wgid % NXCD, off = wgid / NXCD; wgid = (xcd < r ? xcd * (q + 1) : r * (q + 1) + (xcd - r) * q) + off; }
        const int nig = WGM * nN, gid = wgid / nig, fm = gid * WGM, gsz = (nM - fm) < WGM ? (nM - fm) : WGM;
        u.pm = fm + ((wgid % nig) % gsz); u.pn = (wgid % nig) / gsz; u.koff = 0; u.nt = 0; return true;
    }
    __device__ __forceinline__ void a_ready(const Unit&) const {}
    __device__ __forceinline__ void done(const Unit&) const {}
};

__device__ __forceinline__ unsigned cvt_pk_bf16(float lo, float hi) { unsigned r; asm volatile("v_cvt_pk_bf16_f32 %0, %1, %2" : "=v"(r) : "v"(lo), "v"(hi)); return r; }
template <class Epi, class Sched, bool ALIGN_EPI = false, bool SP2 = false>
__device__ __forceinline__ void gemm_phase(PG8_LAS unsigned char* lds, const Gemm g, const Sched& S, const Epi& E) {
    const int tid = threadIdx.x, wid = __builtin_amdgcn_readfirstlane(tid >> 6), lane = tid & 63, wr = wid >> 2, wc = wid & 3, fr = lane & 15, fq = lane >> 4;
    const int K = g.K;
    unsigned voffA[2], voffB[2];
#pragma unroll
    for (int i = 0; i < 2; ++i) { int R, C; stage_rc(tid * 16 + i * 8192, R, C); const int Rb = Epi::PERM ? ((R & ~31) + perm32(R & 31)) : R;
        voffA[i] = (unsigned)(R * g.ld + C) * 2u; voffB[i] = (unsigned)(Rb * g.ld + C) * 2u; }
    const size_t kstep = (size_t)(BK * 2);
    const size_t hstep = (size_t)HALF * g.ld * 2;
    const size_t tstep = 2 * hstep;
    const unsigned ldsw = (unsigned)wid * 1024u;
    const int aoff = lds_byte(wr * 64 + fr, fq * 8), boff = lds_byte(wc * 32 + fr, fq * 8);
#define PG8_SA(b, h) (((b) * 2 + (h)) * HTB)
#define PG8_SB(b, h) ((4 + (b) * 2 + (h)) * HTB)
#define PG8_STAGE(bufoff, gbase, voff) do { _Pragma("unroll") for (int _i = 0; _i < 2; ++_i) \
        __builtin_amdgcn_global_load_lds((const unsigned*)((const char*)(gbase) + (voff)[_i]), (PG8_LAS unsigned*)(lds + (bufoff) + ldsw + _i * 8192), 16, 0, 0); } while (0)
#define PG8_LDA(dst, b, h) do { _Pragma("unroll") for (int m = 0; m < 4; ++m) _Pragma("unroll") for (int k = 0; k < 2; ++k) dst[m][k] = *(const PG8_LAS bf16x8*)(lds + PG8_SA(b, h) + aoff + m * 2048 + k * 1024); } while (0)
#define PG8_LDB(dst, b, h) do { _Pragma("unroll") for (int n = 0; n < 2; ++n) _Pragma("unroll") for (int k = 0; k < 2; ++k) dst[n][k] = *(const PG8_LAS bf16x8*)(lds + PG8_SB(b, h) + boff + n * 2048 + k * 1024); } while (0)
#define PG8_MMA(ai, bj, At, Bt) do { __builtin_amdgcn_s_setprio(1); _Pragma("unroll") for (int m = 0; m < 4; ++m) _Pragma("unroll") for (int n = 0; n < 2; ++n) _Pragma("unroll") for (int k = 0; k < 2; ++k) \
        acc[ai][bj][m][n] = __builtin_amdgcn_mfma_f32_16x16x32_bf16(Bt[n][k], At[m][k], acc[ai][bj][m][n], 0, 0, 0); __builtin_amdgcn_s_setprio(0); } while (0)
#define PG8_WAIT_V(n) asm volatile("s_waitcnt vmcnt(" #n ")" ::: "memory")
#define PG8_WAIT_L(n) asm volatile("s_waitcnt lgkmcnt(" #n ")" ::: "memory")
#define PG8_BAR __builtin_amdgcn_s_barrier()
#define PG8_SCHED __builtin_amdgcn_sched_barrier(0)
    Unit cur, nxt; int ui = 0;
    if (!S.next(0, cur)) return;
    f32x4 acc[2][2][4][2];
#pragma unroll
    for (int a = 0; a < 2; ++a)
#pragma unroll
        for (int b = 0; b < 2; ++b)
#pragma unroll
            for (int m = 0; m < 4; ++m)
#pragma unroll
                for (int n = 0; n < 2; ++n) acc[a][b][m][n] = (f32x4){0.f, 0.f, 0.f, 0.f};
    bf16x8 At[4][2], B0[2][2], B1[2][2];
    const char* cA = (const char*)g.A + (size_t)cur.pm * tstep + (size_t)cur.koff * 2; const char* cB = (const char*)g.Bt + (size_t)cur.pn * tstep + (size_t)cur.koff * 2;
    S.a_ready(cur);
    if constexpr (SP2) {
        PG8_STAGE(PG8_SB(0, 0), cB, voffB); PG8_STAGE(PG8_SB(0, 1), cB + hstep, voffB); PG8_STAGE(PG8_SA(0, 0), cA, voffA); PG8_STAGE(PG8_SA(0, 1), cA + hstep, voffA);
        if (wr == 1) PG8_BAR;
        PG8_WAIT_V(2); PG8_BAR;
        PG8_STAGE(PG8_SB(1, 0), cB + kstep, voffB); PG8_STAGE(PG8_SA(1, 0), cA + kstep, voffA); PG8_STAGE(PG8_SB(1, 1), cB + hstep + kstep, voffB);
        PG8_WAIT_V(6); PG8_BAR;
    } else {
        PG8_STAGE(PG8_SB(0, 0), cB, voffB); PG8_STAGE(PG8_SA(0, 0), cA, voffA); PG8_STAGE(PG8_SB(0, 1), cB + hstep, voffB); PG8_STAGE(PG8_SA(0, 1), cA + hstep, voffA);
        if (wr == 1) PG8_BAR;
        PG8_WAIT_V(4); PG8_BAR;
        PG8_STAGE(PG8_SB(1, 0), cB + kstep, voffB); PG8_STAGE(PG8_SA(1, 0), cA + kstep, voffA); PG8_STAGE(PG8_SB(1, 1), cB + hstep + kstep, voffB);
        PG8_WAIT_V(6); PG8_BAR;
    }
    for (;;) {
        const bool has_next = S.next(ui + 1, nxt);
        const int nt = cur.nt ? cur.nt : K / BK;
        const char* nA = has_next ? (const char*)g.A + (size_t)nxt.pm * tstep + (size_t)nxt.koff * 2 : cA; const char* nB = has_next ? (const char*)g.Bt + (size_t)nxt.pn * tstep + (size_t)nxt.koff * 2 : cB;
        for (int t = 0; t < nt; t += 2) {
            const bool last = (t == nt - 2);
            const char* a1 = cA + (size_t)(t + 1) * kstep;
            const char* a2 = last ? nA : cA + (size_t)(t + 2) * kstep; const char* b2 = last ? nB : cB + (size_t)(t + 2) * kstep;
            const char* a3 = a2 + kstep; const char* b3 = b2 + kstep;
            if (last && has_next) S.a_ready(nxt);
            if constexpr (SP2) {
            PG8_LDB(B0, 0, 0); PG8_LDB(B1, 0, 1); PG8_SCHED; PG8_LDA(At, 0, 0); PG8_STAGE(PG8_SA(1, 1), a1 + hstep, voffA);
            PG8_WAIT_V(8); PG8_WAIT_L(0); PG8_BAR; PG8_MMA(0, 0, At, B0); PG8_MMA(0, 1, At, B1); PG8_BAR; PG8_SCHED;
            PG8_LDA(At, 0, 1); PG8_STAGE(PG8_SB(0, 0), b2, voffB); PG8_STAGE(PG8_SB(0, 1), b2 + hstep, voffB); PG8_STAGE(PG8_SA(0, 0), a2, voffA);
            PG8_WAIT_V(8); PG8_WAIT_L(0); PG8_BAR; PG8_MMA(1, 0, At, B0); PG8_MMA(1, 1, At, B1); PG8_BAR; PG8_SCHED;
            PG8_LDB(B0, 1, 0); PG8_LDB(B1, 1, 1); PG8_SCHED; PG8_LDA(At, 1, 0); PG8_STAGE(PG8_SA(0, 1), a2 + hstep, voffA);
            PG8_WAIT_V(8); PG8_WAIT_L(0); PG8_BAR; PG8_MMA(0, 0, At, B0); PG8_MMA(0, 1, At, B1); PG8_BAR; PG8_SCHED;
            PG8_LDA(At, 1, 1); PG8_STAGE(PG8_SB(1, 0), b3, voffB); PG8_STAGE(PG8_SB(1, 1), b3 + hstep, voffB); PG8_STAGE(PG8_SA(1, 0), a3, voffA);
            PG8_WAIT_V(8); PG8_WAIT_L(0); PG8_BAR; PG8_MMA(1, 0, At, B0); PG8_MMA(1, 1, At, B1); PG8_BAR; PG8_SCHED;
            } else {
            PG8_LDB(B0, 0, 0); PG8_SCHED; PG8_LDA(At, 0, 0); PG8_STAGE(PG8_SA(1, 1), a1 + hstep, voffA);
            PG8_WAIT_L(8); PG8_BAR; PG8_WAIT_L(0); PG8_MMA(0, 0, At, B0); PG8_BAR; PG8_SCHED;
            PG8_LDB(B1, 0, 1); PG8_STAGE(PG8_SB(0, 0), b2, voffB);
            PG8_BAR; PG8_WAIT_L(0); PG8_MMA(0, 1, At, B1); PG8_BAR;
            PG8_LDA(At, 0, 1); PG8_STAGE(PG8_SA(0, 0), a2, voffA);
            PG8_BAR; PG8_WAIT_L(0); PG8_MMA(1, 0, At, B0); PG8_BAR; PG8_SCHED;
            PG8_STAGE(PG8_SB(0, 1), b2 + hstep, voffB);
            PG8_WAIT_V(6); PG8_BAR; PG8_MMA(1, 1, At, B1); PG8_BAR;
            PG8_LDB(B0, 1, 0); PG8_SCHED; PG8_LDA(At, 1, 0); PG8_STAGE(PG8_SA(0, 1), a2 + hstep, voffA);
            PG8_WAIT_L(8); PG8_BAR; PG8_WAIT_L(0); PG8_MMA(0, 0, At, B0); PG8_BAR; PG8_SCHED;
            PG8_LDB(B1, 1, 1); PG8_STAGE(PG8_SB(1, 0), b3, voffB);
            PG8_BAR; PG8_WAIT_L(0); PG8_MMA(0, 1, At, B1); PG8_BAR;
            PG8_LDA(At, 1, 1); PG8_STAGE(PG8_SA(1, 0), a3, voffA);
            PG8_BAR; PG8_WAIT_L(0); PG8_MMA(1, 0, At, B0); PG8_BAR; PG8_SCHED;
            PG8_STAGE(PG8_SB(1, 1), b3 + hstep, voffB);
            PG8_WAIT_V(6); PG8_BAR; PG8_MMA(1, 1, At, B1); PG8_BAR;
            }
        }
        if constexpr (ALIGN_EPI) { if (wr == 0) PG8_BAR; }
        if constexpr (!Epi::AFTER_DRAIN) { E(acc, cur, wr, wc, fr, fq); S.done(cur); }
        if (!has_next) break;
#pragma unroll
        for (int a = 0; a < 2; ++a)
#pragma unroll
            for (int b = 0; b < 2; ++b)
#pragma unroll
                for (int m = 0; m < 4; ++m)
#pragma unroll
                    for (int n = 0; n < 2; ++n) acc[a][b][m][n] = (f32x4){0.f, 0.f, 0.f, 0.f};
        cur = nxt; cA = nA; cB = nB; ++ui;
        if constexpr (ALIGN_EPI) { if (wr == 1) PG8_BAR; }
    }
    PG8_WAIT_V(0);
    if constexpr (!ALIGN_EPI) { if (wr == 0) PG8_BAR; }
    PG8_BAR;
    if constexpr (Epi::AFTER_DRAIN) { E.fused(acc, cur, wr, wc, fr, fq, lds, wid, lane); S.done(cur); }
#undef PG8_SA
#undef PG8_SB
#undef PG8_STAGE
#undef PG8_LDA
#undef PG8_LDB
#undef PG8_MMA
#undef PG8_WAIT_V
#undef PG8_WAIT_L
#undef PG8_BAR
#undef PG8_SCHED
}
}

#define GAS __attribute__((address_space(1)))
#define LAS __attribute__((address_space(3)))
typedef unsigned short bf16;
typedef float f32x4 __attribute__((ext_vector_type(4)));
typedef float f32x16 __attribute__((ext_vector_type(16)));
typedef short bf16x8 __attribute__((ext_vector_type(8)));
typedef short v4i16_t __attribute__((ext_vector_type(4)));
typedef unsigned u32x4 __attribute__((ext_vector_type(4)));
typedef unsigned u32x2 __attribute__((ext_vector_type(2)));

constexpr int DM = 1024, NB = 8, SEQ = 2048, DB = 32, DS = 16, PAST = 1024, DC = 512, DA = 512, NH = 8, HD = 64, CW = 31, DFF = 2816, INC = 2568;
constexpr int MP = NB * SEQ, MS = DB * DS, MT = MP + MS;
constexpr int NIN = 2560, NGU = 2 * DFF, SKV = PAST + DS;
constexpr int NMODB = NB + DB;
constexpr int MOD_SH1 = 0, MOD_SC1 = 1024, MOD_G1 = 2048, MOD_SH2 = 3072, MOD_SC2 = 4096, MOD_G2 = 5120;
constexpr float EPS = 1e-6f, LOG2E = 1.4426950408889634f, QSCALE = 0.125f * 1.4426950408889634f, NEG_BIG = -1e30f;
constexpr size_t OFF_YP = 0, OFF_YS = OFF_YP + (size_t)MP * DM, OFF_KP = OFF_YS + (size_t)MS * DM, OFF_VP = OFF_KP + (size_t)MP * DA, OFF_LP = OFF_VP + (size_t)MP * DA,
                 OFF_CP = OFF_LP + (size_t)MP * NH, OFF_KS = OFF_CP + (size_t)NB * 30 * DC, OFF_VS = OFF_KS + (size_t)MS * DA, OFF_LS = OFF_VS + (size_t)MS * DA,
                 OFF_CS = OFF_LS + (size_t)MS * NH, OUT_TOTAL = OFF_CS + (size_t)DB * 30 * DC;
constexpr size_t MiB = 1u << 20;
constexpr size_t WS_MOD = 0;
constexpr size_t WS_CUMP = 1 * MiB;
constexpr size_t WS_CUMS = 2 * MiB;
constexpr size_t WS_WIN = 4 * MiB, WS_WOUT = 9 * MiB, WS_WGU = 11 * MiB, WS_WDN = 22 * MiB;
constexpr size_t WS_H = 28 * MiB;
constexpr size_t WS_X1 = 61 * MiB;
constexpr size_t WS_U = 127 * MiB;
constexpr size_t WS_Q = 160 * MiB, WS_K = WS_Q + 16 * MiB + MiB / 2, WS_V = WS_K + 16 * MiB + MiB / 2;
constexpr size_t WS_MIX = 210 * MiB;
constexpr size_t WS_ACT = 127 * MiB;
constexpr size_t WS_END = 243 * MiB;
constexpr size_t WS_SLAB4 = WS_U;
constexpr size_t WS_SLAB7 = WS_H;
static_assert(WS_V + (size_t)MT * DA * 2 <= WS_MIX && WS_ACT + (size_t)MT * DFF * 2 <= WS_END && WS_MIX + (size_t)MT * DM * 2 <= WS_END, "ws map");
constexpr int LDS_BYTES = 147456;
constexpr int LDS_AUX = 131072;

#define LDS_WAIT() asm volatile("s_waitcnt lgkmcnt(0)" ::: "memory")
__device__ __forceinline__ unsigned f2bf(float f) { unsigned u = __builtin_bit_cast(unsigned, f); return (u + 0x7fffu + ((u >> 16) & 1u)) >> 16; }
typedef float f32x2_t __attribute__((ext_vector_type(2))); typedef __bf16 bf16x2_t __attribute__((ext_vector_type(2)));
__device__ __forceinline__ unsigned pk2(float lo, float hi) { f32x2_t v = {lo, hi}; bf16x2_t b = __builtin_convertvector(v, bf16x2_t); return __builtin_bit_cast(unsigned, b); }
__device__ __forceinline__ float wave_sum(float v) {
#pragma unroll
    for (int o = 1; o < 64; o <<= 1) v += __shfl_xor(v, o);
    return v;
}
__device__ __forceinline__ float sigmoidf_(float x) { return __builtin_amdgcn_rcpf(1.0f + __expf(-x)); }

struct Params {
    const float* in[24];
    float* out;
    unsigned char* ws;
    int ph_lo, ph_hi;
};

struct EpiIn {
    static constexpr bool PERM = false, AFTER_DRAIN = false;
    float* u; bf16* qkv; float* out; const float* qg; long kg_minus_qg;
    __device__ __forceinline__ void operator()(const pg8::f32x4 (&acc)[2][2][4][2], const pg8::Unit& un, int wr, int wc, int fr, int fq) const {
        const int row0 = un.pm * 256 + wr * 64 + fr, pn = un.pn;
        if (pn < 4) {
            const bool samp = un.pm >= MP / 256, tailp = (un.pm & 7) == 7;
#pragma unroll
            for (int ai = 0; ai < 2; ++ai)
#pragma unroll
                for (int m = 0; m < 4; ++m) {
                    const int row = row0 + ai * 128 + m * 16, col = pn * 128 + wc * 32 + 4 * fq;
                    bf16* rp = (bf16*)u + (size_t)row * DC + col;
                    float* cp = nullptr;
                    if (samp) { const int rr = row - MP; cp = out + OFF_CS + ((size_t)(rr >> 4) * 30 + (30 - DS) + (rr & 15)) * DC + col; }
                    else if (tailp && (row & (SEQ - 1)) >= SEQ - 30) cp = out + OFF_CP + ((size_t)(row >> 11) * 30 + ((row & (SEQ - 1)) - (SEQ - 30))) * DC + col;
#pragma unroll
                    for (int n = 0; n < 2; ++n) { const f32x4 a = acc[ai][0][m][n], g = acc[ai][1][m][n]; f32x4 r;
#pragma unroll
                        for (int j = 0; j < 4; ++j) r[j] = a[j] * sigmoidf_(g[j]);
                        u32x2 w; w.x = pk2(r[0], r[1]); w.y = pk2(r[2], r[3]);
                        *(u32x2*)(rp + n * 16) = w;
                        if (cp) *(f32x4*)(cp + n * 16) = r; }
                }
        } else {
            const int t = (pn - 4) >> 1, head = 4 * ((pn - 4) & 1) + wc;
            const float* gsrc = qg + (t == 0 ? 0L : kg_minus_qg);
            const float gs = (t == 0) ? QSCALE : 1.f;
            f32x4 gam00 = *(const f32x4*)(gsrc + head * 64 + 4 * fq) * gs, gam01 = *(const f32x4*)(gsrc + head * 64 + 16 + 4 * fq) * gs,
                  gam10 = *(const f32x4*)(gsrc + head * 64 + 32 + 4 * fq) * gs, gam11 = *(const f32x4*)(gsrc + head * 64 + 48 + 4 * fq) * gs;
            if (t == 2) { gam00 = (f32x4){1.f, 1.f, 1.f, 1.f}; gam01 = gam00; gam10 = gam00; gam11 = gam00; }
            bf16* bdst = qkv + (size_t)t * ((WS_K - WS_Q) / 2);
            const bool prompt = un.pm < (MP / 256);
            float* fbase = out + (t == 1 ? (prompt ? OFF_KP : OFF_KS) : (prompt ? OFF_VP : OFF_VS));
#pragma unroll
            for (int ai = 0; ai < 2; ++ai)
#pragma unroll
                for (int m = 0; m < 4; ++m) {
                    const int row = row0 + ai * 128 + m * 16;
                    float rstd = 1.f;
                    if (t < 2) { float ss = 0.f;
#pragma unroll
                        for (int bj = 0; bj < 2; ++bj)
#pragma unroll
                            for (int n = 0; n < 2; ++n) { const f32x4 x = acc[ai][bj][m][n]; ss += (x[0] * x[0] + x[1] * x[1]) + (x[2] * x[2] + x[3] * x[3]); }
                        ss += __shfl_xor(ss, 16); ss += __shfl_xor(ss, 32);
                        rstd = rsqrtf(ss * (1.0f / 64.0f) + EPS); }
                    const size_t frow = (size_t)(prompt ? row : row - MP) * DA + head * 64 + 4 * fq;
                    bf16* bp = bdst + (size_t)row * DA + head * 64 + 4 * fq;
#pragma unroll
                    for (int bj = 0; bj < 2; ++bj)
#pragma unroll
                        for (int n = 0; n < 2; ++n) { f32x4 v = acc[ai][bj][m][n] * rstd * (bj == 0 ? (n == 0 ? gam00 : gam01) : (n == 0 ? gam10 : gam11));
                            if (t > 0) *(f32x4*)(fbase + frow + 32 * bj + 16 * n) = v;
                            u32x2 w; w.x = pk2(v[0], v[1]); w.y = pk2(v[2], v[3]);
                            *(u32x2*)(bp + 32 * bj + 16 * n) = w; }
                }
        }
    }
};
__device__ __forceinline__ int mod_row_of(int row) { return row < MP ? (row >> 11) : NB + ((row - MP) >> 4); }
template <bool DST_BF16, bool BASE_BF16> struct EpiRes {
    static constexpr bool PERM = false, AFTER_DRAIN = false;
    const float* base_p; const float* base_s; float* dst_p; float* dst_s; const float* gate;
    __device__ __forceinline__ void operator()(const pg8::f32x4 (&acc)[2][2][4][2], const pg8::Unit& un, int wr, int wc, int fr, int fq) const {
        const int row0 = un.pm * 256 + wr * 64 + fr, col0 = un.pn * 256 + wc * 32 + 4 * fq;
        const float* gp = gate + (size_t)(un.pm >> 3) * 6144 + col0;
        f32x4 gv[4];
#pragma unroll
        for (int q = 0; q < 4; ++q) gv[q] = *(const f32x4*)(gp + (q >> 1) * 128 + (q & 1) * 16);
#pragma unroll
        for (int ai = 0; ai < 2; ++ai) {
            f32x4 bv[4][4];
#pragma unroll
            for (int m = 0; m < 4; ++m)
#pragma unroll
                for (int q = 0; q < 4; ++q) { const size_t o = (size_t)(row0 + ai * 128 + m * 16) * DM + col0 + (q >> 1) * 128 + (q & 1) * 16;
                    if (BASE_BF16) { const u32x2 w = *(const u32x2*)((const bf16*)base_p + o); bv[m][q] = (f32x4){__uint_as_float(w.x << 16), __uint_as_float(w.x & 0xffff0000u), __uint_as_float(w.y << 16), __uint_as_float(w.y & 0xffff0000u)}; }
                    else bv[m][q] = *(const f32x4*)(base_p + o); }
#pragma unroll
            for (int m = 0; m < 4; ++m)
#pragma unroll
                for (int q = 0; q < 4; ++q) { const size_t o = (size_t)(row0 + ai * 128 + m * 16) * DM + col0 + (q >> 1) * 128 + (q & 1) * 16; const f32x4 r = bv[m][q] + gv[q] * acc[ai][q >> 1][m][q & 1];
                    if (DST_BF16) { u32x2 w; w.x = pk2(r[0], r[1]); w.y = pk2(r[2], r[3]); *(u32x2*)((bf16*)dst_p + o) = w; } else *(f32x4*)(dst_p + o) = r; }
        }
    }
};
struct ResOrder {
    pg8::StaticOrder so; int nsub, ksub;
    __device__ __forceinline__ bool next(int i, pg8::Unit& u) const {
        const long L = (long)i * so.G + so.c; if (L < so.nwg) return so.next(i, u);
        const int s = (int)(L - so.nwg); if (s >= nsub) return false;
        u.pm = MP / 256 + (s & 1); u.pn = (s >> 1) & 3; u.koff = (s >> 3) * ksub; u.nt = ksub / 64; return true; }
    __device__ __forceinline__ void a_ready(const pg8::Unit&) const {}
    __device__ __forceinline__ void done(const pg8::Unit&) const {}
};
struct EpiSlab {
    static constexpr bool PERM = false, AFTER_DRAIN = false;
    float* slab;
    __device__ __forceinline__ void operator()(const pg8::f32x4 (&acc)[2][2][4][2], const pg8::Unit& un, int wr, int wc, int fr, int fq) const {
        const int row0 = un.pm * 256 + wr * 64 + fr - MP, col0 = un.pn * 256 + wc * 32 + 4 * fq;
        float* sp = slab + (size_t)(un.koff >> 8) * MS * DM;
#pragma unroll
        for (int ai = 0; ai < 2; ++ai)
#pragma unroll
            for (int m = 0; m < 4; ++m) { float* dp = sp + (size_t)(row0 + ai * 128 + m * 16) * DM + col0;
#pragma unroll
                for (int bj = 0; bj < 2; ++bj)
#pragma unroll
                    for (int n = 0; n < 2; ++n) *(f32x4*)(dp + bj * 128 + n * 16) = acc[ai][bj][m][n]; }
    }
};
template <bool DST_BF16, bool BASE_BF16> struct EpiRes2 {
    static constexpr bool PERM = false, AFTER_DRAIN = false;
    EpiRes<DST_BF16, BASE_BF16> res; EpiSlab slab;
    __device__ __forceinline__ void operator()(const pg8::f32x4 (&acc)[2][2][4][2], const pg8::Unit& un, int wr, int wc, int fr, int fq) const {
        if (un.pm < MP / 256) res(acc, un, wr, wc, fr, fq); else slab(acc, un, wr, wc, fr, fq); }
};
struct EpiGU {
    static constexpr bool PERM = false, AFTER_DRAIN = false;
    bf16* act;
    __device__ __forceinline__ void operator()(const pg8::f32x4 (&acc)[2][2][4][2], const pg8::Unit& un, int wr, int wc, int fr, int fq) const {
        const int row0 = un.pm * 256 + wr * 64 + fr;
#pragma unroll
        for (int ai = 0; ai < 2; ++ai)
#pragma unroll
            for (int m = 0; m < 4; ++m) {
                bf16* rp = act + (size_t)(row0 + ai * 128 + m * 16) * DFF + un.pn * 128 + wc * 32 + 4 * fq;
#pragma unroll
                for (int n = 0; n < 2; ++n) { const f32x4 g = acc[ai][0][m][n], up = acc[ai][1][m][n]; float r[4];
#pragma unroll
                    for (int j = 0; j < 4; ++j) r[j] = g[j] * sigmoidf_(g[j]) * up[j];
                    u32x2 w; w.x = pk2(r[0], r[1]); w.y = pk2(r[2], r[3]);
                    *(u32x2*)(rp + n * 16) = w; }
            }
    }
};

__device__ __forceinline__ void p0_transpose_item(const float* W, int ldw, int K, bf16* WT, int dest_row0, int k0, int n0, LAS float* scr, int lane) {
    { f32x4 wv4[8];
#pragma unroll
        for (int i = 0; i < 8; ++i) wv4[i] = *(const f32x4*)(W + (size_t)(k0 + 8 * i + (lane >> 3)) * ldw + n0 + 4 * (lane & 7));
#pragma unroll
        for (int i = 0; i < 8; ++i) { LAS float* d = scr + (8 * i + (lane >> 3)) * 33 + 4 * (lane & 7); d[0] = wv4[i][0]; d[1] = wv4[i][1]; d[2] = wv4[i][2]; d[3] = wv4[i][3]; } }
    LDS_WAIT();
    const int c = lane & 7;
#pragma unroll
    for (int j = 0; j < 4; ++j) { const int n = (lane >> 3) + 8 * j; const LAS float* s = scr + (8 * c) * 33 + n;
        u32x4 o; o.x = pk2(s[0 * 33], s[1 * 33]); o.y = pk2(s[2 * 33], s[3 * 33]); o.z = pk2(s[4 * 33], s[5 * 33]); o.w = pk2(s[6 * 33], s[7 * 33]);
        *(u32x4*)(WT + (size_t)(dest_row0 + n) * K + k0 + 8 * c) = o; }
    LDS_WAIT();
}
__device__ __forceinline__ int win_dest(int n0) {
    if (n0 < 512) return 256 * (n0 >> 7) + (n0 & 127);
    if (n0 < 1024) { const int j = n0 - 512; return 256 * (j >> 7) + 128 + (j & 127); }
    const int c = n0 - 1024, t = c >> 9, cc = c & 511, hh = cc >> 6, d = cc & 63;
    return 256 * (4 + 2 * t + (hh >> 2)) + 128 * (d >> 5) + 32 * (hh & 3);
}
__device__ __forceinline__ void p0_phase(const Params& P, LAS unsigned char* lds) {
    const int tid = threadIdx.x, lane = tid & 63, wave = __builtin_amdgcn_readfirstlane(tid >> 6);
    float* mod = (float*)(P.ws + WS_MOD);
    for (int it = blockIdx.x; it < 192; it += gridDim.x) {
        const int n0 = it * 32, c = lane & 31, kp = lane >> 5;
        f32x16 ac0, ac1;
#pragma unroll
        for (int r = 0; r < 16; ++r) { ac0[r] = 0.f; ac1[r] = 0.f; }
        LAS float* sl = (LAS float*)lds;
        for (int half = 0; half < 2; ++half) {
            float wreg[32];
            const float* wp = P.in[8] + (size_t)(half * 512 + wave * 64 + kp) * 6144 + n0 + c;
#pragma unroll
            for (int i = 0; i < 32; ++i) wreg[i] = wp[(size_t)(2 * i) * 6144];
            f32x4 cr[10];
#pragma unroll
            for (int j = 0; j < 10; ++j) { const int bb = 4 * j + (tid >> 7), k4 = tid & 127;
                cr[j] = (j < 2) ? *(const f32x4*)(P.in[6] + (size_t)bb * DM + half * 512 + 4 * k4) : *(const f32x4*)(P.in[7] + (size_t)(bb - NB) * DM + half * 512 + 4 * k4); }
            __syncthreads();
            typedef float f32x2w __attribute__((ext_vector_type(2)));
#pragma unroll
            for (int j = 0; j < 10; ++j) { const int bb = 4 * j + (tid >> 7), k4 = tid & 127;
                *(LAS f32x2w*)(sl + bb * 512 + 2 * k4) = (f32x2w){cr[j][0], cr[j][2]}; *(LAS f32x2w*)(sl + bb * 512 + 256 + 2 * k4) = (f32x2w){cr[j][1], cr[j][3]}; }
            __syncthreads();
#pragma unroll 4
            for (int i = 0; i < NMODB; ++i) { const float x = sl[tid + 512 * i]; sl[tid + 512 * i] = x * sigmoidf_(x); }
            __syncthreads();
            const int bl = lane & 31, bl1 = (32 + bl < NMODB) ? 32 + bl : NMODB - 1;
            const LAS float* sb0 = sl + bl * 512 + kp * 256 + wave * 32;
            const LAS float* sb1 = sl + bl1 * 512 + kp * 256 + wave * 32;
#pragma unroll
            for (int blk = 0; blk < 4; ++blk) {
                u32x4 aw; aw.x = pk2(wreg[8 * blk], wreg[8 * blk + 1]); aw.y = pk2(wreg[8 * blk + 2], wreg[8 * blk + 3]); aw.z = pk2(wreg[8 * blk + 4], wreg[8 * blk + 5]); aw.w = pk2(wreg[8 * blk + 6], wreg[8 * blk + 7]);
                const f32x4 x0 = *(const LAS f32x4*)(sb0 + 8 * blk), x1 = *(const LAS f32x4*)(sb0 + 8 * blk + 4), y0 = *(const LAS f32x4*)(sb1 + 8 * blk), y1 = *(const LAS f32x4*)(sb1 + 8 * blk + 4);
                u32x4 b0, b1; b0.x = pk2(x0[0], x0[1]); b0.y = pk2(x0[2], x0[3]); b0.z = pk2(x1[0], x1[1]); b0.w = pk2(x1[2], x1[3]);
                b1.x = pk2(y0[0], y0[1]); b1.y = pk2(y0[2], y0[3]); b1.z = pk2(y1[0], y1[1]); b1.w = pk2(y1[2], y1[3]);
                ac0 = __builtin_amdgcn_mfma_f32_32x32x16_bf16(__builtin_bit_cast(bf16x8, aw), __builtin_bit_cast(bf16x8, b0), ac0, 0, 0, 0);
                ac1 = __builtin_amdgcn_mfma_f32_32x32x16_bf16(__builtin_bit_cast(bf16x8, aw), __builtin_bit_cast(bf16x8, b1), ac1, 0, 0, 0);
            }
        }
        __syncthreads();
        LAS float* red = (LAS float*)lds;
#pragma unroll
        for (int r = 0; r < 16; ++r) { const int ci = (r & 3) + 8 * (r >> 2) + 4 * kp, bq = lane & 31;
            red[(wave * NMODB + bq) * 32 + ci] = ac0[r]; if (bq < NMODB - 32) red[(wave * NMODB + 32 + bq) * 32 + ci] = ac1[r]; }
        __syncthreads();
        for (int o = tid; o < NMODB * 32; o += 512) { const int b = o >> 5, l = o & 31; float sum = P.in[9][n0 + l];
#pragma unroll
            for (int w = 0; w < 8; ++w) sum += red[(w * NMODB + b) * 32 + l];
            mod[(size_t)b * 6144 + n0 + l] = sum; }
        __syncthreads();
    }
}
constexpr int I_IN = 16 * 80, I_OUT = 16 * 32, I_G = 16 * 88, I_D = 44 * 32, NITEMS = I_IN + I_OUT + 2 * I_G + I_D;
__device__ __forceinline__ void convert_items(const Params& P, LAS unsigned char* lds, int it0, int it1, int worker, int nworkers) {
    const int lane = threadIdx.x & 63, wave = __builtin_amdgcn_readfirstlane(threadIdx.x >> 6);
    LAS float* scr = (LAS float*)(lds + wave * 16384);
    for (int it = it0 + worker; it < it1; it += nworkers) {
        int r = it;
        if (r < I_IN) { const int kb = r / 80, nb = r % 80; p0_transpose_item(P.in[11], INC, DM, (bf16*)(P.ws + WS_WIN), win_dest(32 * nb), 64 * kb, 32 * nb, scr, lane); continue; } r -= I_IN;
        if (r < I_OUT) { const int kb = r / 32, nb = r % 32; p0_transpose_item(P.in[19], DM, DM, (bf16*)(P.ws + WS_WOUT), 32 * nb, 64 * kb, 32 * nb, scr, lane); continue; } r -= I_OUT;
        if (r < I_G) { const int kb = r / 88, nb = r % 88, n0 = 32 * nb; p0_transpose_item(P.in[21], DFF, DM, (bf16*)(P.ws + WS_WGU), 256 * (n0 >> 7) + (n0 & 127), 64 * kb, n0, scr, lane); continue; } r -= I_G;
        if (r < I_G) { const int kb = r / 88, nb = r % 88, n0 = 32 * nb; p0_transpose_item(P.in[22], DFF, DM, (bf16*)(P.ws + WS_WGU), 256 * (n0 >> 7) + 128 + (n0 & 127), 64 * kb, n0, scr, lane); continue; } r -= I_G;
        { const int kb = r / 32, nb = r % 32; p0_transpose_item(P.in[23], DM, DFF, (bf16*)(P.ws + WS_WDN), 32 * nb, 64 * kb, 32 * nb, scr, lane); }
    }
}

template <bool SLAB4>
__device__ __forceinline__ void norm_load_row(const float* xp, const float* xs, const float* slab, const float* g1mod, int row, int lane, f32x4 (&d)[4]) {
    if (SLAB4 && row < MP) { const bf16* xr = (const bf16*)xp + (size_t)row * DM;
#pragma unroll
        for (int j = 0; j < 4; ++j) { const u32x2 w = *(const u32x2*)(xr + 256 * j + 4 * lane); d[j] = (f32x4){__uint_as_float(w.x << 16), __uint_as_float(w.x & 0xffff0000u), __uint_as_float(w.y << 16), __uint_as_float(w.y & 0xffff0000u)}; }
    } else if (!SLAB4) { const float* xr = (row < MP) ? xp + (size_t)row * DM : xs + (size_t)(row - MP) * DM;
#pragma unroll
        for (int j = 0; j < 4; ++j) d[j] = *(const f32x4*)(xr + 256 * j + 4 * lane);
    } else { const int r = row - MP; const float* gp = g1mod + (size_t)mod_row_of(row) * 6144;
        f32x4 q0[4], q1[4], q2[4], q3[4], xr4[4], gg[4];
#pragma unroll
        for (int j = 0; j < 4; ++j) { const int c = 256 * j + 4 * lane; const float* sp = slab + (size_t)r * DM + c;
            q0[j] = *(const f32x4*)sp; q1[j] = *(const f32x4*)(sp + (size_t)MS * DM); q2[j] = *(const f32x4*)(sp + (size_t)2 * MS * DM); q3[j] = *(const f32x4*)(sp + (size_t)3 * MS * DM);
            xr4[j] = *(const f32x4*)(xs + (size_t)r * DM + c); gg[j] = *(const f32x4*)(gp + c); }
#pragma unroll
        for (int j = 0; j < 4; ++j) d[j] = xr4[j] + gg[j] * ((q0[j] + q1[j]) + (q2[j] + q3[j]));
    }
}
template <bool WITH_F, bool SLAB4>
__device__ __forceinline__ void norm_phase(const Params& P, LAS unsigned char* lds, const float* xp, const float* xs, const float* gain, int off_sh, int off_sc, const float* slab, const float* g1mod, float* x1s) {
    const int tid = threadIdx.x, lane = tid & 63, wave = __builtin_amdgcn_readfirstlane(tid >> 6);
    const float* mod = (const float*)(P.ws + WS_MOD);
    bf16* hout = (bf16*)(P.ws + WS_H);
    LAS float* wf = (LAS float*)lds;
    const int gw = blockIdx.x * 8 + wave, NGW = gridDim.x * 8;
    const float bfv = WITH_F ? P.in[12][lane >> 3] : 0.f;
    f32x4 gn[4];
#pragma unroll
    for (int j = 0; j < 4; ++j) gn[j] = *(const f32x4*)(gain + 256 * j + 4 * lane);
    f32x4 bA[4], bB[4];
    if (gw < MT) norm_load_row<SLAB4>(xp, xs, slab, g1mod, gw, lane, bA);
    if (gw + NGW < MT) norm_load_row<SLAB4>(xp, xs, slab, g1mod, gw + NGW, lane, bB);
    if (WITH_F) {
#pragma unroll
        for (int e = tid; e < DM * 2; e += 512) { const int k = e >> 1, hh = e & 1; *(LAS f32x4*)(wf + hh * 4096 + ((((k & 3) * 4 + (k >> 8)) * 64 + ((k & 255) >> 2)) * 4)) = *(const f32x4*)(P.in[11] + (size_t)k * INC + NIN + hh * 4); }
        __syncthreads();
    }
    for (int row0 = gw; row0 < MT; row0 += 2 * NGW) {
#pragma unroll
      for (int hh = 0; hh < 2; ++hh) {
        const int row = row0 + hh * NGW;
        if (row < MT) {
        f32x4 v[4];
#pragma unroll
        for (int j = 0; j < 4; ++j) v[j] = hh ? bB[j] : bA[j];
        const float* mr = mod + (size_t)mod_row_of(row) * 6144;
        f32x4 scv[4], shv[4];
#pragma unroll
        for (int j = 0; j < 4; ++j) { scv[j] = *(const f32x4*)(mr + off_sc + 256 * j + 4 * lane); shv[j] = *(const f32x4*)(mr + off_sh + 256 * j + 4 * lane); }
        __builtin_amdgcn_sched_barrier(0);
        { const int nrow = row + 2 * NGW; if (nrow < MT) { if (hh) norm_load_row<SLAB4>(xp, xs, slab, g1mod, nrow, lane, bB); else norm_load_row<SLAB4>(xp, xs, slab, g1mod, nrow, lane, bA); } }
        __builtin_amdgcn_sched_barrier(0);
        float ss = 0.f;
#pragma unroll
        for (int j = 0; j < 4; ++j) { if (SLAB4 && row >= MP) *(f32x4*)(x1s + (size_t)(row - MP) * DM + 256 * j + 4 * lane) = v[j]; ss += (v[j][0] * v[j][0] + v[j][1] * v[j][1]) + (v[j][2] * v[j][2] + v[j][3] * v[j][3]); }
        const float rstd = rsqrtf(wave_sum(ss) * (1.0f / DM) + EPS);
        float f[8];
#pragma unroll
        for (int q = 0; q < 8; ++q) f[q] = 0.f;
#pragma unroll
        for (int j = 0; j < 4; ++j) { const int c = 256 * j + 4 * lane;
            const f32x4 g = gn[j], sc = scv[j], sh = shv[j];
            const f32x4 h = v[j] * rstd * g * (sc + 1.0f) + sh;
            u32x2 w; w.x = pk2(h[0], h[1]); w.y = pk2(h[2], h[3]);
            *(u32x2*)(hout + (size_t)row * DM + c) = w;
            if (WITH_F) {
#pragma unroll
                for (int e = 0; e < 4; ++e) { const f32x4 a = *(const LAS f32x4*)(wf + ((e * 4 + j) * 64 + lane) * 4), b = *(const LAS f32x4*)(wf + 4096 + ((e * 4 + j) * 64 + lane) * 4);
                    f[0] += h[e] * a[0]; f[1] += h[e] * a[1]; f[2] += h[e] * a[2]; f[3] += h[e] * a[3]; f[4] += h[e] * b[0]; f[5] += h[e] * b[1]; f[6] += h[e] * b[2]; f[7] += h[e] * b[3]; }
            }
        }
        if (WITH_F) {
            const bool b5 = (lane & 32) != 0, b4 = (lane & 16) != 0, b3 = (lane & 8) != 0;
            float g4[4], h2[2];
#pragma unroll
            for (int q = 0; q < 4; ++q) { const float snd = b5 ? f[q] : f[q + 4], kp = b5 ? f[q + 4] : f[q]; g4[q] = kp + __shfl_xor(snd, 32); }
#pragma unroll
            for (int q = 0; q < 2; ++q) { const float snd = b4 ? g4[q] : g4[q + 2], kp = b4 ? g4[q + 2] : g4[q]; h2[q] = kp + __shfl_xor(snd, 16); }
            float z; { const float snd = b3 ? h2[0] : h2[1], kp = b3 ? h2[1] : h2[0]; z = kp + __shfl_xor(snd, 8); }
            z += __shfl_xor(z, 4); z += __shfl_xor(z, 2); z += __shfl_xor(z, 1);
            if ((lane & 7) == 0) { const int hq = lane >> 3; z += bfv;
                const float lf = fminf(z, 0.f) - log1pf(__expf(-fabsf(z)));
                float* lo = (row < MP) ? P.out + OFF_LP + (size_t)row * NH : P.out + OFF_LS + (size_t)(row - MP) * NH;
                lo[hq] = lf; }
        }
        }
      }
    }
}

__device__ __forceinline__ void cumsum_items(const Params& P) {
    const int tid = threadIdx.x, lane = tid & 63, wave = __builtin_amdgcn_readfirstlane(tid >> 6);
    if (wave != 0) return;
    float* cump = (float*)(P.ws + WS_CUMP); float* cums = (float*)(P.ws + WS_CUMS);
    for (int it = (int)gridDim.x - 1 - (int)blockIdx.x; it < NB + DB; it += gridDim.x) {
        if (it < NB) {
            const int b = it; const float* src = P.out + OFF_LP + ((size_t)b * SEQ + 32 * lane) * NH;
            float tot[8];
#pragma unroll
            for (int h = 0; h < 8; ++h) tot[h] = 0.f;
#pragma unroll 16
            for (int t = 0; t < 32; ++t) { const f32x4 a = *(const f32x4*)(src + t * 8), c = *(const f32x4*)(src + t * 8 + 4);
                tot[0] += a[0]; tot[1] += a[1]; tot[2] += a[2]; tot[3] += a[3]; tot[4] += c[0]; tot[5] += c[1]; tot[6] += c[2]; tot[7] += c[3]; }
            float run[8];
#pragma unroll
            for (int h = 0; h < 8; ++h) { float s = tot[h];
#pragma unroll
                for (int o = 1; o < 64; o <<= 1) { const float y = __shfl_up(s, o); if (lane >= o) s += y; }
                run[h] = s - tot[h]; }
#pragma unroll 2
            for (int t4 = 0; t4 < 32; t4 += 4) {
                f32x4 o[8];
#pragma unroll
                for (int e = 0; e < 4; ++e) { const f32x4 a = *(const f32x4*)(src + (t4 + e) * 8), c = *(const f32x4*)(src + (t4 + e) * 8 + 4);
                    run[0] += a[0]; run[1] += a[1]; run[2] += a[2]; run[3] += a[3]; run[4] += c[0]; run[5] += c[1]; run[6] += c[2]; run[7] += c[3];
#pragma unroll
                    for (int h = 0; h < 8; ++h) o[h][e] = run[h] * LOG2E; }
#pragma unroll
                for (int h = 0; h < 8; ++h) *(f32x4*)(cump + ((size_t)(b * NH + h)) * SEQ + 32 * lane + t4) = o[h];
            }
        } else {
            const int b = it - NB; const float* src = P.in[4] + ((size_t)b * PAST + 16 * lane) * NH;
            float tot[8];
#pragma unroll
            for (int h = 0; h < 8; ++h) tot[h] = 0.f;
#pragma unroll
            for (int t = 0; t < 16; ++t) { const f32x4 a = *(const f32x4*)(src + t * 8), c = *(const f32x4*)(src + t * 8 + 4);
                tot[0] += a[0]; tot[1] += a[1]; tot[2] += a[2]; tot[3] += a[3]; tot[4] += c[0]; tot[5] += c[1]; tot[6] += c[2]; tot[7] += c[3]; }
            float run[8], all[8];
#pragma unroll
            for (int h = 0; h < 8; ++h) { float s = tot[h];
#pragma unroll
                for (int o = 1; o < 64; o <<= 1) { const float y = __shfl_up(s, o); if (lane >= o) s += y; }
                run[h] = s - tot[h]; all[h] = __shfl(s, 63); }
#pragma unroll 2
            for (int t4 = 0; t4 < 16; t4 += 4) {
                f32x4 o[8];
#pragma unroll
                for (int e = 0; e < 4; ++e) { const f32x4 a = *(const f32x4*)(src + (t4 + e) * 8), c = *(const f32x4*)(src + (t4 + e) * 8 + 4);
                    run[0] += a[0]; run[1] += a[1]; run[2] += a[2]; run[3] += a[3]; run[4] += c[0]; run[5] += c[1]; run[6] += c[2]; run[7] += c[3];
#pragma unroll
                    for (int h = 0; h < 8; ++h) o[h][e] = run[h] * LOG2E; }
#pragma unroll
                for (int h = 0; h < 8; ++h) *(f32x4*)(cums + ((size_t)(b * NH + h)) * SKV + 16 * lane + t4) = o[h];
            }
            const float* ns = P.out + OFF_LS + (size_t)b * DS * NH;
            for (int t = 0; t < DS; ++t) { const f32x4 a = *(const f32x4*)(ns + t * 8), c = *(const f32x4*)(ns + t * 8 + 4);
                all[0] += a[0]; all[1] += a[1]; all[2] += a[2]; all[3] += a[3]; all[4] += c[0]; all[5] += c[1]; all[6] += c[2]; all[7] += c[3];
                if (lane == t) {
#pragma unroll
                    for (int h = 0; h < 8; ++h) cums[((size_t)(b * NH + h)) * SKV + PAST + t] = all[h] * LOG2E; } }
        }
    }
}

__device__ __forceinline__ int crow(int r, int hi) { return (r & 3) + 8 * (r >> 2) + 4 * hi; }
constexpr float ATT_THR = 16.0f;
__device__ __forceinline__ void attn_tile(const LAS unsigned char* Kt, const LAS unsigned char* Vt, const LAS float* ck, float& cqm, int kv0, int qpos, bool need_mask,
                                          const bf16x8 (&qf)[4], f32x16& o0, f32x16& o1, float& m_run, float& l_run, int lane) {
    const int r32 = lane & 31, hi = lane >> 5;
    bf16x8 kf[8];
#pragma unroll
    for (int d0 = 0; d0 < 4; ++d0) { kf[2 * d0] = *(const LAS bf16x8*)(Kt + (2 * d0 + hi) * 1024 + r32 * 16); kf[2 * d0 + 1] = *(const LAS bf16x8*)(Kt + (2 * d0 + hi) * 1024 + 512 + r32 * 16); }
    f32x16 p0, p1;
#pragma unroll
    for (int g = 0; g < 4; ++g) { const f32x4 c0 = *(const LAS f32x4*)(ck + 8 * g + 4 * hi), c1 = *(const LAS f32x4*)(ck + 32 + 8 * g + 4 * hi);
#pragma unroll
        for (int j = 0; j < 4; ++j) { p0[4 * g + j] = cqm - c0[j]; p1[4 * g + j] = cqm - c1[j]; } }
    __builtin_amdgcn_sched_barrier(0);
#pragma unroll
    for (int d0 = 0; d0 < 4; ++d0) {
        p0 = __builtin_amdgcn_mfma_f32_32x32x16_bf16(kf[2 * d0], qf[d0], p0, 0, 0, 0);
        p1 = __builtin_amdgcn_mfma_f32_32x32x16_bf16(kf[2 * d0 + 1], qf[d0], p1, 0, 0, 0);
    }
    const LAS unsigned char* vb = Vt + (4 * hi + ((lane & 15) >> 2)) * 64 + ((lane >> 4) & 1) * 32 + (lane & 3) * 8;
    v4i16_t vlo[8], vhi[8];
#pragma unroll
    for (int d0b = 0; d0b < 2; ++d0b)
#pragma unroll
        for (int sk = 0; sk < 4; ++sk) {
            vlo[d0b * 4 + sk] = __builtin_amdgcn_ds_read_tr16_b64_v4i16((LAS v4i16_t*)(vb + d0b * 4096 + sk * 1024));
            vhi[d0b * 4 + sk] = __builtin_amdgcn_ds_read_tr16_b64_v4i16((LAS v4i16_t*)(vb + d0b * 4096 + sk * 1024 + 512)); }
    __builtin_amdgcn_sched_barrier(0);
    if (need_mask) {
#pragma unroll
        for (int r = 0; r < 16; ++r) { const int kv = kv0 + crow(r, hi); if (kv > qpos) p0[r] = NEG_BIG; if (kv + 32 > qpos) p1[r] = NEG_BIG; }
    }
    float mxa = __builtin_fmaxf(__builtin_fmaxf(p0[0], p0[1]), p1[0]), mxb = __builtin_fmaxf(__builtin_fmaxf(p0[2], p0[3]), p1[1]);
    mxa = __builtin_fmaxf(__builtin_fmaxf(mxa, p1[2]), p1[3]);
#pragma unroll
    for (int r = 4; r < 16; r += 4) { mxa = __builtin_fmaxf(__builtin_fmaxf(mxa, p0[r]), p0[r + 1]); mxb = __builtin_fmaxf(__builtin_fmaxf(mxb, p0[r + 2]), p0[r + 3]);
        mxa = __builtin_fmaxf(__builtin_fmaxf(mxa, p1[r]), p1[r + 1]); mxb = __builtin_fmaxf(__builtin_fmaxf(mxb, p1[r + 2]), p1[r + 3]); }
    float mx = __builtin_fmaxf(mxa, mxb);
    { const auto rr = __builtin_amdgcn_permlane32_swap(__float_as_uint(mx), __float_as_uint(mx), false, false); mx = __builtin_fmaxf(__uint_as_float(rr[0]), __uint_as_float(rr[1])); }
    if (__any(mx > ATT_THR)) {
        const float d = (mx > ATT_THR) ? mx : 0.f, alpha = __builtin_amdgcn_exp2f(-d);
#pragma unroll
        for (int r = 0; r < 16; ++r) { p0[r] -= d; p1[r] -= d; }
        m_run += d; cqm -= d; l_run *= alpha; o0 *= alpha; o1 *= alpha;
    }
    float ls = 0.f;
#pragma unroll
    for (int r = 0; r < 16; ++r) { p0[r] = __builtin_amdgcn_exp2f(p0[r]); p1[r] = __builtin_amdgcn_exp2f(p1[r]); ls += p0[r] + p1[r]; }
    { const auto rr = __builtin_amdgcn_permlane32_swap(__float_as_uint(ls), __float_as_uint(ls), false, false); ls = __uint_as_float(rr[0]) + __uint_as_float(rr[1]); }
    l_run += ls;
    bf16x8 pf[4];
#pragma unroll
    for (int s = 0; s < 2; ++s) {
        u32x4 w0, w1;
        w0.x = pk2(p0[8 * s + 0], p0[8 * s + 1]); w0.y = pk2(p0[8 * s + 2], p0[8 * s + 3]); w0.z = pk2(p0[8 * s + 4], p0[8 * s + 5]); w0.w = pk2(p0[8 * s + 6], p0[8 * s + 7]);
        w1.x = pk2(p1[8 * s + 0], p1[8 * s + 1]); w1.y = pk2(p1[8 * s + 2], p1[8 * s + 3]); w1.z = pk2(p1[8 * s + 4], p1[8 * s + 5]); w1.w = pk2(p1[8 * s + 6], p1[8 * s + 7]);
        pf[s] = __builtin_bit_cast(bf16x8, w0); pf[2 + s] = __builtin_bit_cast(bf16x8, w1);
    }
    __builtin_amdgcn_sched_barrier(0);
#pragma unroll
    for (int d0b = 0; d0b < 2; ++d0b)
#pragma unroll
        for (int sk = 0; sk < 4; ++sk) {
            const v4i16_t lo = vlo[d0b * 4 + sk], hh = vhi[d0b * 4 + sk];
            const bf16x8 a = (bf16x8){lo[0], lo[1], lo[2], lo[3], hh[0], hh[1], hh[2], hh[3]};
            if (d0b == 0) o0 = __builtin_amdgcn_mfma_f32_32x32x16_bf16(a, pf[sk], o0, 0, 0, 0);
            else o1 = __builtin_amdgcn_mfma_f32_32x32x16_bf16(a, pf[sk], o1, 0, 0, 0);
        }
}

__device__ __forceinline__ void attn_prompt_unit(const Params& P, LAS unsigned char* lds, int b, int h, int qblk) {
    const int tid = threadIdx.x, lane = tid & 63, wid = __builtin_amdgcn_readfirstlane(tid >> 6), r32 = lane & 31, hi = lane >> 5;
    const bf16* qb = (const bf16*)(P.ws + WS_Q); const bf16* kb = (const bf16*)(P.ws + WS_K); const bf16* vb = (const bf16*)(P.ws + WS_V);
    bf16* mix = (bf16*)(P.ws + WS_MIX);
    const float* cum = (const float*)(P.ws + WS_CUMP) + (size_t)(b * NH + h) * SEQ;
    const int q0 = qblk * 256, rowbase = b * SEQ, NT = (q0 + 256) / 64;
    LAS float* ckl = (LAS float*)(lds + LDS_AUX);
    const int qrel = q0 + 32 * wid + r32;
    const int kvK = (tid & 7) + 8 * (tid >> 6), cK = (tid >> 3) & 7, cV = (tid & 3) + 4 * ((tid >> 5) & 1), kvV = ((tid >> 2) & 7) + 8 * (tid >> 6);
    const bf16* ksrc = kb + (size_t)(rowbase + kvK) * DA + h * 64 + cK * 8;
    const bf16* vsrc = vb + (size_t)(rowbase + kvV) * DA + h * 64 + cV * 8;
    const int kdst = cK * 1024 + kvK * 16, vdst = 8192 + (cV >> 2) * 4096 + kvV * 64 + (cV & 3) * 16;
    float cv[4];
#pragma unroll
    for (int i = 0; i < 4; ++i) { const int t = tid + 512 * i; cv[i] = (t < q0 + 256) ? cum[t] : 0.f; }
    u32x4 kra = *(const u32x4*)ksrc, vra = *(const u32x4*)vsrc, krb = *(const u32x4*)(ksrc + (size_t)64 * DA), vrb = *(const u32x4*)(vsrc + (size_t)64 * DA);
    bf16x8 qf[4];
#pragma unroll
    for (int d0 = 0; d0 < 4; ++d0) qf[d0] = *(const bf16x8*)(qb + (size_t)(rowbase + qrel) * DA + h * 64 + d0 * 16 + hi * 8);
    float cqm = cum[qrel];
    __builtin_amdgcn_sched_barrier(0);
#pragma unroll
    for (int i = 0; i < 4; ++i) { const int t = tid + 512 * i; if (t < q0 + 256) ckl[t] = cv[i]; }
    *(LAS u32x4*)(lds + kdst) = kra; *(LAS u32x4*)(lds + vdst) = vra; *(LAS u32x4*)(lds + 16384 + kdst) = krb; *(LAS u32x4*)(lds + 16384 + vdst) = vrb;
    __syncthreads();
    f32x16 o0, o1;
#pragma unroll
    for (int r = 0; r < 16; ++r) { o0[r] = 0.f; o1[r] = 0.f; }
    float m_run = 0.f, l_run = 0.f;
    const int qmin = q0 + 32 * wid, qmax = qmin + 31;
    for (int t = 0; t < NT; t += 2) {
        const int tn = (t + 2 < NT) ? t + 2 : t;
        kra = *(const u32x4*)(ksrc + (size_t)tn * 64 * DA); vra = *(const u32x4*)(vsrc + (size_t)tn * 64 * DA);
        krb = *(const u32x4*)(ksrc + (size_t)(tn + 1) * 64 * DA); vrb = *(const u32x4*)(vsrc + (size_t)(tn + 1) * 64 * DA);
        const LAS unsigned char* buf = lds + ((t >> 1) & 1) * 32768;
        if (64 * t <= qmax) attn_tile(buf, buf + 8192, ckl + 64 * t, cqm, 64 * t, qrel, 64 * t + 63 > qmin, qf, o0, o1, m_run, l_run, lane);
        if (64 * (t + 1) <= qmax) attn_tile(buf + 16384, buf + 16384 + 8192, ckl + 64 * (t + 1), cqm, 64 * (t + 1), qrel, 64 * (t + 1) + 63 > qmin, qf, o0, o1, m_run, l_run, lane);
        asm volatile("" ::: "memory"); __builtin_amdgcn_sched_barrier(0);
        { LAS unsigned char* nb = lds + (((t >> 1) + 1) & 1) * 32768;
            *(LAS u32x4*)(nb + kdst) = kra; *(LAS u32x4*)(nb + vdst) = vra; *(LAS u32x4*)(nb + 16384 + kdst) = krb; *(LAS u32x4*)(nb + 16384 + vdst) = vrb; }
        __syncthreads();
    }
    const float inv = 1.0f / l_run;
    bf16* op = mix + (size_t)(rowbase + qrel) * DM + DC + h * 64 + 4 * hi;
#pragma unroll
    for (int g = 0; g < 4; ++g) {
        u32x2 w0, w1;
        w0.x = pk2(o0[4 * g] * inv, o0[4 * g + 1] * inv); w0.y = pk2(o0[4 * g + 2] * inv, o0[4 * g + 3] * inv);
        w1.x = pk2(o1[4 * g] * inv, o1[4 * g + 1] * inv); w1.y = pk2(o1[4 * g + 2] * inv, o1[4 * g + 3] * inv);
        *(u32x2*)(op + 8 * g) = w0; *(u32x2*)(op + 32 + 8 * g) = w1;
    }
}

__device__ __forceinline__ void attn_sample_unit(const Params& P, LAS unsigned char* lds, int b, int h) {
    const int tid = threadIdx.x, lane = tid & 63, wid = __builtin_amdgcn_readfirstlane(tid >> 6), r32 = lane & 31, hi = lane >> 5;
    const bf16* qb = (const bf16*)(P.ws + WS_Q); const bf16* kb = (const bf16*)(P.ws + WS_K); const bf16* vb = (const bf16*)(P.ws + WS_V);
    bf16* mix = (bf16*)(P.ws + WS_MIX);
    const float* cum = (const float*)(P.ws + WS_CUMS) + (size_t)(b * NH + h) * SKV;
    LAS float* ckl = (LAS float*)(lds + LDS_AUX);
    const int rowbase = MP + b * DS;
    float cv[3];
#pragma unroll
    for (int i = 0; i < 3; ++i) { const int t = tid + 512 * i; cv[i] = (t < SKV) ? cum[t] : 0.f; }
    bf16x8 qf[4];
#pragma unroll
    for (int d0 = 0; d0 < 4; ++d0) { qf[d0] = (bf16x8){0, 0, 0, 0, 0, 0, 0, 0}; if (r32 < DS) qf[d0] = *(const bf16x8*)(qb + (size_t)(rowbase + r32) * DA + h * 64 + d0 * 16 + hi * 8); }
    float cqm = (r32 < DS) ? cum[PAST + r32] : 0.f;
    __builtin_amdgcn_sched_barrier(0);
#pragma unroll
    for (int i = 0; i < 3; ++i) { const int t = tid + 512 * i; if (t < 17 * 64) ckl[t] = cv[i]; }
    __syncthreads();
    const int qpos = PAST + r32;
    LAS unsigned char* Kw = lds + wid * 16384; LAS unsigned char* Vw = Kw + 8192;
    f32x16 o0, o1;
#pragma unroll
    for (int r = 0; r < 16; ++r) { o0[r] = 0.f; o1[r] = 0.f; }
    float m_run = 0.f, l_run = 0.f;
    const int ntl = (wid == 0) ? 3 : 2;
    for (int i = 0; i < ntl; ++i) {
        const int t = wid + 8 * i;
        if (t < 16) {
            const float* kc = P.in[2] + ((size_t)(b * PAST + 64 * t) * NH + h) * HD;
            const float* vc = P.in[3] + ((size_t)(b * PAST + 64 * t) * NH + h) * HD;
            {
                const int kvl = (lane >> 1) & 7, cl = lane >> 4, half = lane & 1, f4 = lane & 7, kvv = (lane >> 3) & 7;
                f32x4 xk[16], xv[16];
#pragma unroll
                for (int rg = 0; rg < 8; ++rg)
#pragma unroll
                    for (int ch = 0; ch < 2; ++ch) xk[rg * 2 + ch] = *(const f32x4*)(kc + (size_t)(8 * rg + kvl) * (NH * HD) + (4 * ch + cl) * 8 + half * 4);
#pragma unroll
                for (int rg = 0; rg < 8; ++rg)
#pragma unroll
                    for (int dh = 0; dh < 2; ++dh) xv[rg * 2 + dh] = *(const f32x4*)(vc + (size_t)(8 * rg + kvv) * (NH * HD) + 32 * dh + 4 * f4);
#pragma unroll
                for (int rg = 0; rg < 8; ++rg)
#pragma unroll
                    for (int ch = 0; ch < 2; ++ch) { const f32x4 y = xk[rg * 2 + ch]; u32x2 w; w.x = pk2(y[0], y[1]); w.y = pk2(y[2], y[3]);
                        *(LAS u32x2*)(Kw + (4 * ch + cl) * 1024 + (8 * rg + kvl) * 16 + half * 8) = w; }
#pragma unroll
                for (int rg = 0; rg < 8; ++rg)
#pragma unroll
                    for (int dh = 0; dh < 2; ++dh) { const f32x4 y = xv[rg * 2 + dh]; u32x2 w; w.x = pk2(y[0], y[1]); w.y = pk2(y[2], y[3]);
                        *(LAS u32x2*)(Vw + dh * 4096 + (8 * rg + kvv) * 64 + f4 * 8) = w; } }
        } else {
#pragma unroll
            for (int e = 0; e < 16; ++e) *(LAS u32x4*)(Kw + (e * 64 + lane) * 16) = (u32x4){0u, 0u, 0u, 0u};
            LDS_WAIT();
#pragma unroll
            for (int e = 0; e < 2; ++e) { const int item = lane + 64 * e, row = item & 15, c = item >> 4;
                const u32x4 kk = *(const u32x4*)(kb + (size_t)(rowbase + row) * DA + h * 64 + c * 8), vv = *(const u32x4*)(vb + (size_t)(rowbase + row) * DA + h * 64 + c * 8);
                *(LAS u32x4*)(Kw + c * 1024 + row * 16) = kk; *(LAS u32x4*)(Vw + (c >> 2) * 4096 + row * 64 + (c & 3) * 16) = vv; }
        }
        LDS_WAIT();
        attn_tile(Kw, Vw, ckl + 64 * t, cqm, 64 * t, qpos, t == 16, qf, o0, o1, m_run, l_run, lane);
        LDS_WAIT();
    }
    __syncthreads();
    LAS float* OS = (LAS float*)lds;
    LAS float* MS_ = (LAS float*)(lds + 32768);
    if (r32 < DS) {
#pragma unroll
        for (int g = 0; g < 4; ++g) {
            *(LAS f32x4*)(OS + (wid * 16 + r32) * 64 + 8 * g + 4 * hi) = (f32x4){o0[4 * g], o0[4 * g + 1], o0[4 * g + 2], o0[4 * g + 3]};
            *(LAS f32x4*)(OS + (wid * 16 + r32) * 64 + 32 + 8 * g + 4 * hi) = (f32x4){o1[4 * g], o1[4 * g + 1], o1[4 * g + 2], o1[4 * g + 3]};
        }
        if (hi == 0) { MS_[wid * 16 + r32] = m_run; MS_[128 + wid * 16 + r32] = l_run; }
    }
    __syncthreads();
    { const int q = tid >> 5, d = 2 * (tid & 31);
        float m = MS_[q];
#pragma unroll
        for (int w = 1; w < 8; ++w) m = fmaxf(m, MS_[w * 16 + q]);
        float L = 0.f, a0 = 0.f, a1 = 0.f;
#pragma unroll
        for (int w = 0; w < 8; ++w) { const float sc = __builtin_amdgcn_exp2f(MS_[w * 16 + q] - m); L += MS_[128 + w * 16 + q] * sc;
            a0 += OS[(w * 16 + q) * 64 + d] * sc; a1 += OS[(w * 16 + q) * 64 + d + 1] * sc; }
        const float inv = 1.0f / L;
        *(unsigned*)(mix + (size_t)(rowbase + q) * DM + DC + h * 64 + d) = pk2(a0 * inv, a1 * inv);
    }
    __syncthreads();
}

template <int TPW, int NPASS>
__device__ __forceinline__ void conv_item(const Params& P, LAS unsigned char* lds, bool sample, int b, int t0) {
    constexpr int NTOK = 8 * TPW * NPASS, NR = NTOK + 32, NST = NR * 64 / 512;
    const int tid = threadIdx.x, lane = tid & 63, wid = __builtin_amdgcn_readfirstlane(tid >> 6);
    const bf16* u = (const bf16*)(P.ws + WS_U);
    bf16* mix = (bf16*)(P.ws + WS_MIX);
    const int rowbase = sample ? MP + b * DS : b * SEQ;
    u32x4 sv[NST];
#pragma unroll
    for (int i = 0; i < NST; ++i) { const int e = tid + 512 * i, r = e >> 6, c8 = e & 63, t = t0 - 30 + r;
        sv[i] = (u32x4){0u, 0u, 0u, 0u};
        if (r < NTOK + 30) {
            if (t >= 0) sv[i] = *(const u32x4*)(u + (size_t)(rowbase + t) * DC + 8 * c8);
            else if (sample) { const float* sp = P.in[5] + ((size_t)b * 30 + (30 + t)) * DC + 8 * c8; const f32x4 x0 = *(const f32x4*)sp, x1 = *(const f32x4*)(sp + 4);
                sv[i] = (u32x4){pk2(x0[0], x0[1]), pk2(x0[2], x0[3]), pk2(x1[0], x1[1]), pk2(x1[2], x1[3])}; } } }
#pragma unroll
    for (int i = 0; i < NST; ++i) { const int e = tid + 512 * i; *(LAS u32x4*)(lds + (e >> 6) * 1024 + (e & 63) * 16) = sv[i]; }
    constexpr int WOFF = NR * 1024;
    { f32x4 wr[8];
#pragma unroll
        for (int i = 0; i < 8; ++i) { const int e = tid + 512 * i, r = e >> 7, c4 = e & 127; wr[i] = (f32x4){0.f, 0.f, 0.f, 0.f}; if (r < CW) wr[i] = *(const f32x4*)(P.in[15] + (size_t)r * DC + 4 * c4); }
#pragma unroll
        for (int i = 0; i < 8; ++i) { const int e = tid + 512 * i, r = e >> 7, c4 = e & 127; u32x2 w; w.x = pk2(wr[i][0], wr[i][1]); w.y = pk2(wr[i][2], wr[i][3]); *(LAS u32x2*)(lds + WOFF + r * 1024 + c4 * 8) = w; } }
    __syncthreads();
    const LAS unsigned char* wl = lds + WOFF + lane * 4;
    typedef float f32x2v __attribute__((ext_vector_type(2)));
    float cb[8], lg[8], lb[8];
#pragma unroll
    for (int i = 0; i < 4; ++i) { const f32x2v a = *(const f32x2v*)(P.in[16] + 2 * lane + 128 * i), g = *(const f32x2v*)(P.in[17] + 2 * lane + 128 * i), c = *(const f32x2v*)(P.in[18] + 2 * lane + 128 * i);
        cb[2 * i] = a[0]; cb[2 * i + 1] = a[1]; lg[2 * i] = g[0]; lg[2 * i + 1] = g[1]; lb[2 * i] = c[0]; lb[2 * i + 1] = c[1]; }
#pragma unroll 1
    for (int pass = 0; pass < NPASS; ++pass) {
    const int tok0 = (wid * NPASS + pass) * TPW;
    float acc[TPW][8];
#pragma unroll
    for (int k = 0; k < TPW; ++k)
#pragma unroll
        for (int i = 0; i < 8; ++i) acc[k][i] = 0.f;
    float wv[4][8];
#pragma unroll
    for (int s = 0; s < 4; ++s)
#pragma unroll
        for (int i = 0; i < 8; ++i) wv[s][i] = 0.f;
    const LAS unsigned char* ub = lds + tok0 * 1024 + lane * 4;
    constexpr int NM = ((TPW + 30 + 3) / 4) * 4;
#pragma unroll 1
    for (int mb = 0; mb < NM; mb += 4) {
#pragma unroll
        for (int s = 0; s < 4; ++s) {
            const int m = mb + s, mw = (m <= 30) ? m : 31;
#pragma unroll
            for (int i = 0; i < 4; ++i) { const unsigned x = *(const LAS unsigned*)(wl + mw * 1024 + 256 * i); wv[s][2 * i] = __uint_as_float(x << 16); wv[s][2 * i + 1] = __uint_as_float(x & 0xffff0000u); }
            float uv[8];
#pragma unroll
            for (int i = 0; i < 4; ++i) { const unsigned x = *(const LAS unsigned*)(ub + m * 1024 + 256 * i); uv[2 * i] = __uint_as_float(x << 16); uv[2 * i + 1] = __uint_as_float(x & 0xffff0000u); }
#pragma unroll
            for (int k = 0; k < TPW; ++k)
#pragma unroll
                for (int i = 0; i < 8; ++i) acc[k][i] += uv[i] * wv[(s - k) & 3][i];
        }
    }
#pragma unroll
    for (int kg = 0; kg < TPW; kg += 4) {
        float st[8];
#pragma unroll
        for (int q = 0; q < 8; ++q) st[q] = 0.f;
#pragma unroll
        for (int k = 0; k < 4; ++k) if (kg + k < TPW) {
            float s1 = 0.f, s2 = 0.f;
#pragma unroll
            for (int i = 0; i < 8; ++i) { acc[kg + k][i] += cb[i]; s1 += acc[kg + k][i]; s2 += acc[kg + k][i] * acc[kg + k][i]; }
            st[k] = s1; st[4 + k] = s2; }
        float zt;
        { const bool b5 = (lane & 32) != 0, b4 = (lane & 16) != 0, b3 = (lane & 8) != 0; float g4[4], h2[2];
#pragma unroll
            for (int q = 0; q < 4; ++q) { const float snd = b5 ? st[q] : st[q + 4], kp = b5 ? st[q + 4] : st[q]; g4[q] = kp + __shfl_xor(snd, 32); }
#pragma unroll
            for (int q = 0; q < 2; ++q) { const float snd = b4 ? g4[q] : g4[q + 2], kp = b4 ? g4[q + 2] : g4[q]; h2[q] = kp + __shfl_xor(snd, 16); }
            { const float snd = b3 ? h2[0] : h2[1], kp = b3 ? h2[1] : h2[0]; zt = kp + __shfl_xor(snd, 8); }
            zt += __shfl_xor(zt, 4); zt += __shfl_xor(zt, 2); zt += __shfl_xor(zt, 1); }
#pragma unroll
        for (int k = 0; k < 4; ++k) if (kg + k < TPW) {
            const float sum1 = __uint_as_float(__builtin_amdgcn_readlane(__float_as_uint(zt), 8 * k)), sum2 = __uint_as_float(__builtin_amdgcn_readlane(__float_as_uint(zt), 8 * (4 + k)));
            const float mu = sum1 * (1.0f / DC), var = fmaxf(sum2 * (1.0f / DC) - mu * mu, 0.f);
            const float rstd = rsqrtf(var + EPS);
            bf16* op = mix + (size_t)(rowbase + t0 + tok0 + kg + k) * DM + 2 * lane;
#pragma unroll
            for (int i = 0; i < 4; ++i) { const float y0 = (acc[kg + k][2 * i] - mu) * rstd * lg[2 * i] + lb[2 * i], y1 = (acc[kg + k][2 * i + 1] - mu) * rstd * lg[2 * i + 1] + lb[2 * i + 1];
                *(unsigned*)(op + 128 * i) = pk2(y0 * sigmoidf_(y0), y1 * sigmoidf_(y1)); }
        }
    }
    }
    __syncthreads();
}

__device__ __forceinline__ void p3_phase(const Params& P, LAS unsigned char* lds) {
    const int G = gridDim.x, bx = blockIdx.x;
#ifndef P3PARTS
#define P3PARTS 31
#endif
#ifndef P3REP
#define P3REP 0
#endif
    const bool sample_first = ((bx >> 3) & 1) != 0;
    if (sample_first) {
    for (int r2 = 0; r2 < 1 + ((P3REP >> 1) & 1); ++r2)
    if (P3PARTS & 2) for (int it = bx; it < DB * NH; it += G) attn_sample_unit(P, lds, it >> 3, it & 7);
    }
    for (int r1 = 0; r1 < 1 + (P3REP & 1); ++r1)
    if (P3PARTS & 1) for (int it = bx; it < 256; it += G) { const int itm = (G == 256) ? ((it & 7) * 32 + (it >> 3)) : it;
        const int bh = itm >> 2, p = itm & 3; attn_prompt_unit(P, lds, bh >> 3, bh & 7, 7 - p); attn_prompt_unit(P, lds, bh >> 3, bh & 7, p); }
    for (int r3 = 0; r3 < 1 + ((P3REP >> 2) & 1); ++r3)
    if (P3PARTS & 4) for (int it = bx; it < 256; it += G) conv_item<4, 2>(P, lds, false, it >> 5, (it & 31) * 64);
    if (P3PARTS & 8) for (int it = (bx + G - 32 % G) % G; it < DB; it += G) conv_item<2, 1>(P, lds, true, it, 0);
    if (!sample_first) {
    for (int r2 = 0; r2 < 1 + ((P3REP >> 1) & 1); ++r2)
    if (P3PARTS & 2) for (int it = bx; it < DB * NH; it += G) attn_sample_unit(P, lds, it >> 3, it & 7);
    }
    const int gt = bx * 512 + threadIdx.x, GT = G * 512;
    for (int e = gt; e < DB * (30 - DS) * 128; e += GT) { const int c4 = e & 127, r = (e >> 7) % (30 - DS), b = (e >> 7) / (30 - DS);
        *(f32x4*)(P.out + OFF_CS + ((size_t)b * 30 + r) * DC + 4 * c4) = *(const f32x4*)(P.in[5] + ((size_t)b * 30 + DS + r) * DC + 4 * c4); }
}

constexpr size_t WS_CTL = 3 * MiB + MiB / 2, CTL_BYTES = 16384; static_assert(WS_CUMS + (size_t)DB * NH * SKV * 4 <= WS_CTL && WS_CUMP + (size_t)NB * NH * SEQ * 4 <= WS_CUMS && WS_CTL + CTL_BYTES <= WS_WIN, "ctl map");
constexpr int LDS_MISC = 143360;
#define XB_TMO      128
#define XB_XCNT(j)  (256  + 64 * (j))
#define XB_XSUB(j)  (1280 + 64 * (j))
#define XB_XGEN(j)  (2304 + 64 * (j))
#define XB_TOP      3328
#define XB_TOPGEN   3392
#define XCD_BAR_WORDS 3456
#define XB_SPIN_CAP (1u << 18)

__device__ __forceinline__ unsigned xb_ld(unsigned* p)              { return __hip_atomic_load(p, __ATOMIC_RELAXED, __HIP_MEMORY_SCOPE_AGENT); }
__device__ __forceinline__ unsigned xb_add(unsigned* p, unsigned v) { return __hip_atomic_fetch_add(p, v, __ATOMIC_RELAXED, __HIP_MEMORY_SCOPE_AGENT); }
__device__ __forceinline__ unsigned xb_xcc_id() { return (unsigned)__builtin_amdgcn_s_getreg((3 << 11) | 20) & 0xFu; }
#define XB_SPIN(cond, bar) do { unsigned _sp = 0; while (cond) { __builtin_amdgcn_s_sleep(1); \
    if ((++_sp & 255u) == 0u) { if (xb_ld(&(bar)[XB_TMO])) break; if (_sp > XB_SPIN_CAP) { atomicAdd(&(bar)[XB_TMO], 1u); break; } } } } while (0)

struct XcdBarrier {
    unsigned* bar; unsigned x;
    volatile LAS unsigned* st;
};

__device__ __forceinline__ XcdBarrier xcd_barrier_post(unsigned* bar, volatile LAS unsigned* st) {
    XcdBarrier b; b.bar = bar; b.x = xb_xcc_id(); b.st = st;
    if (threadIdx.x == 0) (void)xb_add(&bar[XB_XCNT(b.x)], 1u);
    return b;
}
__device__ __forceinline__ void xcd_barrier_complete(unsigned* bar, unsigned x, unsigned& nloc, unsigned& nx) {
    const unsigned G = gridDim.x * gridDim.y * gridDim.z;
    unsigned sum, cnt, mine, sp = 0u;
    for (;;) {
        sum = 0u; cnt = 0u; mine = 0u;
#pragma unroll
        for (unsigned j = 0; j < 16; ++j) { const unsigned c = xb_ld(&bar[XB_XCNT(j)]); sum += c; cnt += (c > 0u) ? 1u : 0u; mine = (j == x) ? c : mine; }
        if (sum == G) break;
        __builtin_amdgcn_s_sleep(1);
        if ((++sp & 255u) == 0u) { if (xb_ld(&bar[XB_TMO])) break; if (sp > XB_SPIN_CAP) { atomicAdd(&bar[XB_TMO], 1u); break; } }
    }
    nloc = mine > 0u ? mine : 1u; nx = cnt > 0u ? cnt : 1u;
}

__device__ __forceinline__ void xcd_barrier(const XcdBarrier& b) {
    asm volatile("s_waitcnt vmcnt(0)" ::: "memory");
    __syncthreads();
    if (threadIdx.x == 0) {
        unsigned* bar = b.bar;
        __builtin_amdgcn_s_waitcnt(0);
        unsigned nloc = b.st[0], nx = b.st[1];
        if (nloc == 0u) { xcd_barrier_complete(bar, b.x, nloc, nx); b.st[0] = nloc; b.st[1] = nx; }
        const unsigned old = xb_add(&bar[XB_XSUB(b.x)], 1u);
        const unsigned gen = old / nloc;
        if (old + 1u == (gen + 1u) * nloc) {
            __builtin_amdgcn_fence(__ATOMIC_RELEASE, "agent");
            asm volatile("s_waitcnt vmcnt(0)" ::: "memory");
            const unsigned og = xb_add(&bar[XB_TOP], 1u);
            const unsigned tg = og / nx;
            if (og + 1u == (tg + 1u) * nx) xb_add(&bar[XB_TOPGEN], 1u);
            else XB_SPIN(xb_ld(&bar[XB_TOPGEN]) == tg, bar);
            __builtin_amdgcn_fence(__ATOMIC_ACQUIRE, "agent");
            xb_add(&bar[XB_XGEN(b.x)], 1u);
            asm volatile("s_waitcnt vmcnt(0)" ::: "memory");
        } else {
            XB_SPIN(xb_ld(&bar[XB_XGEN(b.x)]) == gen, bar);
            __builtin_amdgcn_fence(__ATOMIC_ACQUIRE, "agent");
            asm volatile("s_waitcnt vmcnt(0)" ::: "memory");
        }
    }
    __syncthreads();
}


__global__ void __launch_bounds__(512, 2) fwd_megakernel(Params P) {
    extern __shared__ __attribute__((aligned(16))) unsigned char lds_raw[];
    LAS unsigned char* lds = (LAS unsigned char*)lds_raw;
    cg::grid_group grid = cg::this_grid();
    if (threadIdx.x < 16) ((LAS unsigned*)(lds + LDS_MISC))[threadIdx.x] = 0u;
    __syncthreads();
    const XcdBarrier xbar = xcd_barrier_post((unsigned*)(P.ws + WS_CTL), (volatile LAS unsigned*)(lds + LDS_MISC));
    if (P.ph_lo < 0) grid.sync();
    const int lo = P.ph_lo, hi = P.ph_hi;
#ifndef PHMASK
#define PHMASK 0x1FF
#endif
#define IN(k) ((((PHMASK) >> (k)) & 1) && lo <= (k) && (k) < hi)
#ifndef REPMASK
#define REPMASK 0
#endif
#ifndef SYNCREP
#define SYNCREP 1
#endif
#define NREP(k) (1 + (((REPMASK) >> (k)) & 1))
#define SEAM(k) do { if (IN(k) && IN((k) + 1)) for (int sr_ = 0; sr_ < SYNCREP; ++sr_) xcd_barrier(xbar); } while (0)
    float* mod = (float*)(P.ws + WS_MOD);
    if (IN(0)) for (int rep = 0; rep < NREP(0); ++rep) { p0_phase(P, lds);
        {
            const int G = (int)gridDim.x, wv = __builtin_amdgcn_readfirstlane(threadIdx.x >> 6);
            if (G <= 192) convert_items(P, lds, 0, I_IN, (int)blockIdx.x * 8 + wv, G * 8);
            else if ((int)blockIdx.x >= 192) convert_items(P, lds, 0, I_IN, ((int)blockIdx.x - 192) * 8 + wv, (G - 192) * 8);
        } }
    SEAM(0);
    if (IN(1)) for (int rep = 0; rep < NREP(1); ++rep) { norm_phase<true, false>(P, lds, P.in[0], P.in[1], P.in[10], MOD_SH1, MOD_SC1, nullptr, nullptr, nullptr); }
    SEAM(1);
    if (IN(2)) for (int rep = 0; rep < NREP(2); ++rep) {
#ifndef NO_CUMSUM
        cumsum_items(P);
#endif
        pg8::Gemm g{(const pg8::bf16_t*)(P.ws + WS_H), (const pg8::bf16_t*)(P.ws + WS_WIN), MT, NIN, DM, DM}; pg8::StaticOrder S; S.init(MT, NIN, (int)gridDim.x, (int)blockIdx.x);
        EpiIn E{(float*)(P.ws + WS_U), (bf16*)(P.ws + WS_Q), P.out, P.in[13], (long)(P.in[14] - P.in[13])};
        pg8::gemm_phase<EpiIn, pg8::StaticOrder, true, true>(lds, g, S, E);
        {
            const int G = (int)gridDim.x, nun = (MT / 256) * (NIN / 256), rem = nun % G;
            const int wv = __builtin_amdgcn_readfirstlane(threadIdx.x >> 6);
            if (rem == 0) convert_items(P, lds, I_IN, I_IN + I_OUT, (int)blockIdx.x * 8 + wv, G * 8);
            else if ((int)blockIdx.x >= rem) convert_items(P, lds, I_IN, I_IN + I_OUT, ((int)blockIdx.x - rem) * 8 + wv, (G - rem) * 8);
        }
    }
    SEAM(2);
    if (IN(3)) for (int rep = 0; rep < NREP(3); ++rep) { p3_phase(P, lds); }
    SEAM(3);
    if (IN(4)) for (int rep = 0; rep < NREP(4); ++rep) {
        pg8::Gemm g{(const pg8::bf16_t*)(P.ws + WS_MIX), (const pg8::bf16_t*)(P.ws + WS_WOUT), MT, DM, DM, DM};
        ResOrder S; S.so.init(MP, DM, (int)gridDim.x, (int)blockIdx.x); S.nsub = 8 * 4; S.ksub = 256;
        EpiRes2<true, false> E{EpiRes<true, false>{P.in[0], P.in[1], (float*)(P.ws + WS_X1), (float*)(P.ws + WS_X1) + (size_t)MP * DM, mod + MOD_G1}, EpiSlab{(float*)(P.ws + WS_SLAB4)}};
        pg8::gemm_phase<EpiRes2<true, false>, ResOrder, true, true>(lds, g, S, E);
        {
            const int G = (int)gridDim.x, rem = (256 + 8 * 4) % G, wv = __builtin_amdgcn_readfirstlane(threadIdx.x >> 6);
            if (rem == 0) convert_items(P, lds, I_IN + I_OUT, I_IN + I_OUT + 2 * I_G, (int)blockIdx.x * 8 + wv, G * 8);
            else if ((int)blockIdx.x >= rem) convert_items(P, lds, I_IN + I_OUT, I_IN + I_OUT + 2 * I_G, ((int)blockIdx.x - rem) * 8 + wv, (G - rem) * 8);
        }
    }
    SEAM(4);
    if (IN(5)) for (int rep = 0; rep < NREP(5); ++rep) { norm_phase<false, true>(P, lds, (const float*)(P.ws + WS_X1), P.in[1], P.in[20], MOD_SH2, MOD_SC2, (const float*)(P.ws + WS_SLAB4), mod + MOD_G1, (float*)(P.ws + WS_X1) + (size_t)MP * DM);     }
    SEAM(5);
    if (IN(6)) for (int rep = 0; rep < NREP(6); ++rep) {
        pg8::Gemm g{(const pg8::bf16_t*)(P.ws + WS_H), (const pg8::bf16_t*)(P.ws + WS_WGU), MT, NGU, DM, DM}; pg8::StaticOrder S; S.init(MT, NGU, (int)gridDim.x, (int)blockIdx.x);
        EpiGU E{(bf16*)(P.ws + WS_ACT)};
        pg8::gemm_phase<EpiGU, pg8::StaticOrder, true, true>(lds, g, S, E);
        {
            const int G = (int)gridDim.x, rem = ((MT / 256) * (NGU / 256)) % G, wv = __builtin_amdgcn_readfirstlane(threadIdx.x >> 6);
            if (rem == 0) convert_items(P, lds, I_IN + I_OUT + 2 * I_G, NITEMS, (int)blockIdx.x * 8 + wv, G * 8);
            else if ((int)blockIdx.x >= rem) convert_items(P, lds, I_IN + I_OUT + 2 * I_G, NITEMS, ((int)blockIdx.x - rem) * 8 + wv, (G - rem) * 8);
        }
    }
    SEAM(6);
    if (IN(7)) for (int rep = 0; rep < NREP(7); ++rep) {
        pg8::Gemm g{(const pg8::bf16_t*)(P.ws + WS_ACT), (const pg8::bf16_t*)(P.ws + WS_WDN), MT, DM, DFF, DFF};
        ResOrder S; S.so.init(MP, DM, (int)gridDim.x, (int)blockIdx.x); S.nsub = 8 * 11; S.ksub = 256;
        EpiRes2<false, true> E{EpiRes<false, true>{(const float*)(P.ws + WS_X1), (const float*)(P.ws + WS_X1) + (size_t)MP * DM, P.out + OFF_YP, P.out + OFF_YS, mod + MOD_G2}, EpiSlab{(float*)(P.ws + WS_SLAB7)}};
        pg8::gemm_phase<EpiRes2<false, true>, ResOrder, true, true>(lds, g, S, E);
    }
    SEAM(7);
    if (IN(8)) {
        const float* x1s = (const float*)(P.ws + WS_X1) + (size_t)MP * DM; const float* slab = (const float*)(P.ws + WS_SLAB7);
        for (int e = blockIdx.x * 512 + threadIdx.x; e < MS * (DM / 4); e += gridDim.x * 512) { const int r = e >> 8, c = 4 * (e & 255);
            f32x4 sm = *(const f32x4*)(slab + (size_t)r * DM + c);
#pragma unroll
            for (int ks = 1; ks < 11; ++ks) sm += *(const f32x4*)(slab + ((size_t)ks * MS + r) * DM + c);
            *(f32x4*)(P.out + OFF_YS + (size_t)r * DM + c) = *(const f32x4*)(x1s + (size_t)r * DM + c) + *(const f32x4*)(mod + (size_t)mod_row_of(MP + r) * 6144 + MOD_G2 + c) * sm; }
    }
#undef IN
#undef SEAM
}

#ifndef N_LAUNCH_SPLIT
#define N_LAUNCH_SPLIT 0
#endif
extern "C" void kernel_launch(void* const* d_in, const int* in_sizes, int n_in, void* d_out, int out_size, void* d_ws, size_t ws_size, hipStream_t stream) {
    static int grid = 0;
    if (grid == 0) {
        if (n_in != 24 || (size_t)out_size != OUT_TOTAL || ws_size < WS_END) { fprintf(stderr, "kernel_launch: unexpected shapes (n_in %d, out %d, ws %zu)\n", n_in, out_size, ws_size); grid = -1; return; }
        int dev = 0, cus = 0, per_cu = 0;
        (void)hipGetDevice(&dev); (void)hipDeviceGetAttribute(&cus, hipDeviceAttributeMultiprocessorCount, dev);
        if (hipFuncSetAttribute((const void*)fwd_megakernel, hipFuncAttributeMaxDynamicSharedMemorySize, LDS_BYTES) != hipSuccess) { fprintf(stderr, "kernel_launch: hipFuncSetAttribute failed\n"); grid = -1; return; }
        if (hipOccupancyMaxActiveBlocksPerMultiprocessor(&per_cu, (const void*)fwd_megakernel, 512, LDS_BYTES) != hipSuccess || per_cu < 1) { fprintf(stderr, "kernel_launch: occupancy query says %d\n", per_cu); per_cu = 1; }
        (void)hipGetLastError();
        grid = cus * 1;
        if (grid <= 0) grid = 256;
    }
    if (grid < 0) return;
    if (hipMemsetAsync((char*)d_ws + WS_CTL, 0, CTL_BYTES, stream) != hipSuccess) { fprintf(stderr, "kernel_launch: memset failed\n"); return; }
    Params p{};
    for (int i = 0; i < 24; ++i) p.in[i] = (const float*)d_in[i];
    p.out = (float*)d_out; p.ws = (unsigned char*)d_ws;
#if N_LAUNCH_SPLIT
    for (int ph = 0; ph < 9; ++ph) { p.ph_lo = ph; p.ph_hi = ph + 1; hipLaunchKernelGGL(fwd_megakernel, dim3(grid), dim3(512), LDS_BYTES, stream, p); }
#else
    p.ph_lo = 0; p.ph_hi = 9;
    void* args[] = {&p};
    hipError_t e = hipLaunchCooperativeKernel((const void*)fwd_megakernel, dim3(grid), dim3(512), args, LDS_BYTES, stream);
    if (e != hipSuccess) fprintf(stderr, "kernel_launch: cooperative launch failed: %s (grid %d)\n", hipGetErrorString(e), grid);
#endif
}
```
